# Optimizing an MI355X kernel written in HIP

```python
import jax, jax.numpy as jnp
from jax import lax
import numpy as np

D_MODEL = 1024
BATCH = 8
SEQ = 2048
DEPTH = 1
DEC_BATCH = 128
DEC_SEQ = 4
PAST_LEN = 16384
PAGE_SIZE = 128

CHUNK = 128
A_WIDTH = D_MODEL // 2
A_GROUPS = 4
A_GDIM = A_WIDTH // A_GROUPS
POOL_WINDOWS = (2, 4, 8, 16)
B_GROUPS = len(POOL_WINDOWS)
B_WIDTH = D_MODEL // 4
B_GDIM = B_WIDTH // B_GROUPS
POOL_STATE = max(POOL_WINDOWS) - 1
MEM_LEN = 256
C_HEADS = 4
C_WIDTH = D_MODEL // 4
C_HEAD_DIM = C_WIDTH // C_HEADS
N_BRANCH = 3
D_IN = 2 * A_WIDTH + B_WIDTH + C_WIDTH + N_BRANCH * D_MODEL
D_FF = ((8 * D_MODEL // 3) + 127) // 128 * 128
CONV_W = 3
EPS = 1e-6

kernel_name = "hybrid_gmlp_pool_memxattn_decoder_step"


def rmsnorm(x, g):
    xf = x.astype(jnp.float32)
    y = xf * lax.rsqrt(jnp.mean(xf * xf, axis=-1, keepdims=True) + EPS)
    return (y * g.astype(jnp.float32)).astype(x.dtype)


def layernorm(x, g, b):
    xf = x.astype(jnp.float32)
    mu = jnp.mean(xf, axis=-1, keepdims=True)
    var = jnp.mean(jnp.square(xf - mu), axis=-1, keepdims=True)
    y = (xf - mu) * lax.rsqrt(var + EPS)
    return (y * g.astype(jnp.float32) + b.astype(jnp.float32)).astype(x.dtype)


def chunk_spatial(v, w_s, b_s):
    B, T, G, dg = v.shape
    L = min(T, CHUNK)
    nc = T // L
    vc = v.reshape(B, nc, L, G, dg)
    ws = w_s[:, :L, :L] * jnp.tril(jnp.ones((L, L), v.dtype))
    out = jnp.einsum('gts,bcsgd->bctgd', ws, vc) + b_s[:, :L].T[None, None, :, :, None]
    return out.reshape(B, T, G, dg)


def multi_scale_pool(xb_ext, n_prev):
    P = POOL_STATE
    xf = xb_ext.astype(jnp.float32)
    T = xf.shape[1] - P
    cs = jnp.concatenate([jnp.zeros_like(xf[:, :1]), jnp.cumsum(xf, axis=1)], axis=1)
    win = jnp.array(POOL_WINDOWS, dtype=jnp.int32)
    t = jnp.arange(T, dtype=jnp.int32)
    lo_idx = (P + 1 + t)[:, None] - win[None, :]
    lo = cs[:, lo_idx, jnp.arange(B_GROUPS)[None, :]]
    hi = cs[:, P + 1:]
    count = jnp.minimum(win[None, :], t[:, None] + 1 + n_prev).astype(jnp.float32)
    mean = (hi - lo) / count[None, :, :, None]
    return (mean - xf[:, P:]).astype(xb_ext.dtype)


def memory_kv(mem, g_mem, w_kv):
    B = mem.shape[0]
    kv = (rmsnorm(mem, g_mem) @ w_kv).reshape(B, MEM_LEN, 2, C_HEADS, C_HEAD_DIM)
    return kv[:, :, 0], kv[:, :, 1]


def cross_attn(q, k, v):
    s = jnp.einsum('bthd,bmhd->bhtm', q, k).astype(jnp.float32) * (C_HEAD_DIM ** -0.5)
    p = jax.nn.softmax(s, axis=-1).astype(v.dtype)
    return jnp.einsum('bhtm,bmhd->bthd', p, v)


def token_mixer(xn, mem_k, mem_v, pool_prev, n_prev, lp):
    B, T, _ = xn.shape
    proj = xn @ lp['w_in']
    s1 = 2 * A_WIDTH
    s2 = s1 + B_WIDTH
    s3 = s2 + C_WIDTH
    a_part, b_part, q_part, g_part = proj[..., :s1], proj[..., s1:s2], proj[..., s2:s3], proj[..., s3:]
    u, v = jnp.split(jax.nn.gelu(a_part), 2, axis=-1)
    vn = layernorm(v, lp['gmlp_ln_g'], lp['gmlp_ln_b'])
    sg = chunk_spatial(vn.reshape(B, T, A_GROUPS, A_GDIM), lp['w_spatial'], lp['b_spatial']).reshape(B, T, A_WIDTH)
    br_a = (u * sg) @ lp['w_branch_a']
    xb_ext = jnp.concatenate([pool_prev.astype(b_part.dtype), b_part], axis=1)
    pooled = multi_scale_pool(xb_ext.reshape(B, POOL_STATE + T, B_GROUPS, B_GDIM), n_prev)
    mixed = jnp.einsum('btgd,gde->btge', pooled, lp['w_pool']) * lp['pool_scale'].reshape(B_GROUPS, B_GDIM)
    br_b = mixed.reshape(B, T, B_WIDTH) @ lp['w_branch_b']
    new_pool = xb_ext[:, -POOL_STATE:]
    q = q_part.reshape(B, T, C_HEADS, C_HEAD_DIM)
    br_c = cross_attn(q, mem_k, mem_v).reshape(B, T, C_WIDTH) @ lp['w_branch_c']
    gates = jax.nn.sigmoid((g_part + lp['b_gate']).astype(jnp.float32)).astype(xn.dtype).reshape(B, T, N_BRANCH, D_MODEL)
    merged = gates[:, :, 0] * br_a + gates[:, :, 1] * br_b + gates[:, :, 2] * br_c
    return merged @ lp['w_out'], vn, new_pool


def conv_ffn(hn, conv_prev, lp):
    T = hn.shape[1]
    g, u = jnp.split(hn @ lp['w_up'], 2, axis=-1)
    g_ext = jnp.concatenate([conv_prev.astype(g.dtype), g], axis=1)
    c = lp['conv_b'] + sum(lp['conv_w'][k] * g_ext[:, k:k + T] for k in range(CONV_W))
    y = (jax.nn.gelu(c) * u) @ lp['w_down']
    return y, g_ext[:, -(CONV_W - 1):]


def decoder_layer(x, mem_k, mem_v, pool_prev, n_prev, conv_prev, lp):
    mix, vn, new_pool = token_mixer(rmsnorm(x, lp['norm_mix_pre']), mem_k, mem_v, pool_prev, n_prev, lp)
    h = x + rmsnorm(mix, lp['norm_mix_post'])
    f, new_conv = conv_ffn(rmsnorm(h, lp['norm_ffn_pre']), conv_prev, lp)
    out = h + rmsnorm(f, lp['norm_ffn_post'])
    return out, vn, new_pool, new_conv


def setup_inputs(seed: int = 0) -> dict:
    key = jax.random.key(seed)
    ks = jax.random.split(key, 29)
    f32 = jnp.float32

    def nrm(k, shape, scale=1.0):
        return jax.random.normal(k, shape, f32) * scale

    def gain(k, shape):
        return 1.0 + 0.05 * jax.random.normal(k, shape, f32)

    L = DEPTH
    return {
        'x_prompt': nrm(ks[0], (BATCH, SEQ, D_MODEL)),
        'x_sample': nrm(ks[1], (DEC_BATCH, DEC_SEQ, D_MODEL)),
        'mem_prompt': nrm(ks[2], (BATCH, MEM_LEN, D_MODEL)),
        'cache_mem_k': nrm(ks[3], (L, DEC_BATCH, MEM_LEN, C_HEADS, C_HEAD_DIM)),
        'cache_mem_v': nrm(ks[4], (L, DEC_BATCH, MEM_LEN, C_HEADS, C_HEAD_DIM)),
        'state_pool': nrm(ks[5], (L, DEC_BATCH, POOL_STATE, B_WIDTH)),
        'state_conv': nrm(ks[6], (L, DEC_BATCH, CONV_W - 1, D_FF)),
        'norm_mix_pre': gain(ks[7], (L, D_MODEL)),
        'norm_mix_post': gain(ks[8], (L, D_MODEL)),
        'norm_ffn_pre': gain(ks[9], (L, D_MODEL)),
        'norm_ffn_post': gain(ks[10], (L, D_MODEL)),
        'w_in': nrm(ks[11], (L, D_MODEL, D_IN), D_MODEL ** -0.5),
        'b_gate': nrm(ks[12], (L, N_BRANCH * D_MODEL), 0.01),
        'gmlp_ln_g': gain(ks[13], (L, A_WIDTH)),
        'gmlp_ln_b': nrm(ks[14], (L, A_WIDTH), 0.01),
        'w_spatial': nrm(ks[15], (L, A_GROUPS, CHUNK, CHUNK), CHUNK ** -0.5),
        'b_spatial': gain(ks[16], (L, A_GROUPS, CHUNK)),
        'w_pool': nrm(ks[17], (L, B_GROUPS, B_GDIM, B_GDIM), B_GDIM ** -0.5),
        'pool_scale': gain(ks[18], (L, B_WIDTH)),
        'mem_norm': gain(ks[19], (L, D_MODEL)),
        'w_mem_kv': nrm(ks[20], (L, D_MODEL, 2 * C_WIDTH), D_MODEL ** -0.5),
        'w_branch_a': nrm(ks[21], (L, A_WIDTH, D_MODEL), A_WIDTH ** -0.5),
        'w_branch_b': nrm(ks[22], (L, B_WIDTH, D_MODEL), B_WIDTH ** -0.5),
        'w_branch_c': nrm(ks[23], (L, C_WIDTH, D_MODEL), C_WIDTH ** -0.5),
        'w_out': nrm(ks[24], (L, D_MODEL, D_MODEL), D_MODEL ** -0.5),
        'w_up': nrm(ks[25], (L, D_MODEL, 2 * D_FF), D_MODEL ** -0.5),
        'conv_w': nrm(ks[26], (L, CONV_W, D_FF), CONV_W ** -0.5),
        'conv_b': nrm(ks[27], (L, D_FF), 0.01),
        'w_down': nrm(ks[28], (L, D_FF, D_MODEL), D_FF ** -0.5),
    }


def reference(x_prompt, x_sample, mem_prompt, cache_mem_k, cache_mem_v, state_pool, state_conv,
              norm_mix_pre, norm_mix_post, norm_ffn_pre, norm_ffn_post, w_in, b_gate,
              gmlp_ln_g, gmlp_ln_b, w_spatial, b_spatial, w_pool, pool_scale, mem_norm, w_mem_kv,
              w_branch_a, w_branch_b, w_branch_c, w_out, w_up, conv_w, conv_b, w_down):
    hp = x_prompt
    hs = x_sample
    mk_p, mv_p, pool_p, conv_p = [], [], [], []
    v_s, pool_s, conv_s = [], [], []
    for l in range(DEPTH):
        lp = {
            'norm_mix_pre': norm_mix_pre[l], 'norm_mix_post': norm_mix_post[l],
            'norm_ffn_pre': norm_ffn_pre[l], 'norm_ffn_post': norm_ffn_post[l],
            'w_in': w_in[l], 'b_gate': b_gate[l], 'gmlp_ln_g': gmlp_ln_g[l], 'gmlp_ln_b': gmlp_ln_b[l],
            'w_spatial': w_spatial[l], 'b_spatial': b_spatial[l], 'w_pool': w_pool[l],
            'pool_scale': pool_scale[l], 'w_branch_a': w_branch_a[l], 'w_branch_b': w_branch_b[l],
            'w_branch_c': w_branch_c[l], 'w_out': w_out[l], 'w_up': w_up[l], 'conv_w': conv_w[l],
            'conv_b': conv_b[l], 'w_down': w_down[l],
        }
        mk, mv = memory_kv(mem_prompt, mem_norm[l], w_mem_kv[l])
        pool0 = jnp.zeros((hp.shape[0], POOL_STATE, B_WIDTH), hp.dtype)
        conv0 = jnp.zeros((hp.shape[0], CONV_W - 1, D_FF), hp.dtype)
        hp, _, npool_p, nconv_p = decoder_layer(hp, mk, mv, pool0, 0, conv0, lp)
        mk_p.append(mk)
        mv_p.append(mv)
        pool_p.append(npool_p)
        conv_p.append(nconv_p)
        hs, vn_s, npool_s, nconv_s = decoder_layer(hs, cache_mem_k[l], cache_mem_v[l], state_pool[l],
                                                   POOL_STATE, state_conv[l], lp)
        v_s.append(vn_s)
        pool_s.append(npool_s)
        conv_s.append(nconv_s)
    return (hp, hs, jnp.stack(mk_p), jnp.stack(mv_p), jnp.stack(pool_p), jnp.stack(conv_p),
            jnp.stack(v_s), jnp.stack(pool_s), jnp.stack(conv_s))
```

```cpp
#include <hip/hip_runtime.h>
#include <hip/hip_cooperative_groups.h>
#include <cstdio>
namespace cg = cooperative_groups;

#define LAS __attribute__((address_space(3)))
typedef unsigned short bf16_t;
typedef short bf16x8 __attribute__((ext_vector_type(8)));
typedef float f32x4 __attribute__((ext_vector_type(4)));
typedef float f32x2 __attribute__((ext_vector_type(2)));
typedef unsigned u32x4 __attribute__((ext_vector_type(4)));
typedef unsigned u32x2 __attribute__((ext_vector_type(2)));

constexpr int DM = 1024, NPROMPT = 16384, NSAMP = 512, MT = NPROMPT + NSAMP;
constexpr int DIN = 4608, DFF = 2816, NUP = 2 * DFF;
constexpr float EPSV = 1e-6f;
constexpr int LDS_BYTES = 131072 + 8192;

constexpr size_t O_Y = 0, O_MK = 17301504, O_MV = 17825792, O_POOLP = 18350080, O_CONVP = 18380800, O_VS = 18425856, O_POOLS = 18688000, O_CONVS = 19179520;
constexpr size_t WS_WIN = 0, WS_WKV = WS_WIN + 9437184, WS_WBR = WS_WKV + 1048576, WS_WOUT = WS_WBR + 2097152, WS_WUP = WS_WOUT + 2097152,
                 WS_WDOWN = WS_WUP + 11534336, WS_WST = WS_WDOWN + 5767168, WS_R1 = WS_WST + 131072, WS_R2 = WS_R1 + 34603008, WS_R3 = WS_R2 + 34603008,
                 WS_BP = WS_R3 + 103809024, WS_Q = WS_BP + 17301504, WS_MEMN = WS_Q + 8650752, WS_KB = WS_MEMN + 4194304, WS_VT = WS_KB + 1048576,
                 WS_SS1 = WS_VT + 1048576, WS_SS2 = WS_SS1 + 1081344, WS_GRAW = WS_SS2 + 1081344, WS_URAW = WS_GRAW + 5767168, WS_BAR = WS_URAW + 2883584, WS_END = WS_BAR + 256;

struct Params {
    const float* in[29];
    float* out;
    unsigned char* ws;
};

typedef const __attribute__((address_space(4))) Params* KP;
__device__ __forceinline__ KP get_params() { unsigned long long kp = (unsigned long long)__builtin_amdgcn_kernarg_segment_ptr(); asm volatile("" : "+s"(kp)); return (KP)kp; }
__device__ __forceinline__ int ltid() { int t = threadIdx.x; asm volatile("" : "+v"(t)); return t; }
typedef __bf16 bf16x2_t __attribute__((ext_vector_type(2)));
__device__ __forceinline__ unsigned cvt_pk_bf16(float lo, float hi) { f32x2 v = {lo, hi}; bf16x2_t r = __builtin_convertvector(v, bf16x2_t); return __builtin_bit_cast(unsigned, r); }
__device__ __forceinline__ bf16_t f2bf(float x) { return (bf16_t)(cvt_pk_bf16(x, x) & 0xffffu); }
__device__ __forceinline__ float bf2f(bf16_t b) { return __uint_as_float(((unsigned)b) << 16); }
__device__ __forceinline__ float bflo(unsigned w) { return __uint_as_float(w << 16); }
__device__ __forceinline__ float bfhi(unsigned w) { return __uint_as_float(w & 0xffff0000u); }
__device__ __forceinline__ void unpack8(const u32x4 w, f32x4& a, f32x4& b) {
    a[0] = bflo(w[0]); a[1] = bfhi(w[0]); a[2] = bflo(w[1]); a[3] = bfhi(w[1]);
    b[0] = bflo(w[2]); b[1] = bfhi(w[2]); b[2] = bflo(w[3]); b[3] = bfhi(w[3]);
}
__device__ __forceinline__ f32x4 unpack4(const u32x2 w) { f32x4 a; a[0] = bflo(w[0]); a[1] = bfhi(w[0]); a[2] = bflo(w[1]); a[3] = bfhi(w[1]); return a; }
__device__ __forceinline__ u32x2 pack4(const f32x4 v) { u32x2 w; w[0] = cvt_pk_bf16(v[0], v[1]); w[1] = cvt_pk_bf16(v[2], v[3]); return w; }
__device__ __forceinline__ u32x4 pack8(const f32x4 a, const f32x4 b) { u32x4 w; w[0] = cvt_pk_bf16(a[0], a[1]); w[1] = cvt_pk_bf16(a[2], a[3]); w[2] = cvt_pk_bf16(b[0], b[1]); w[3] = cvt_pk_bf16(b[2], b[3]); return w; }
__device__ __forceinline__ float gelu1(float x) {
    const float u = x * (0.7978845608f + 0.0356774081f * x * x);
    const float e = __builtin_amdgcn_exp2f(-2.885390082f * u);
    return x * __builtin_amdgcn_rcpf(1.0f + e);
}
__device__ __forceinline__ f32x4 gelu4(f32x4 v) { f32x4 o; o[0] = gelu1(v[0]); o[1] = gelu1(v[1]); o[2] = gelu1(v[2]); o[3] = gelu1(v[3]); return o; }
__device__ __forceinline__ float sigm1(float x) { x = fminf(fmaxf(x, -30.f), 30.f); return __builtin_amdgcn_rcpf(1.0f + __builtin_amdgcn_exp2f(-1.442695041f * x)); }
__device__ __forceinline__ float wave_sum(float v) {
    v += __shfl_xor(v, 1); v += __shfl_xor(v, 2); v += __shfl_xor(v, 4); v += __shfl_xor(v, 8); v += __shfl_xor(v, 16); v += __shfl_xor(v, 32); return v;
}
__device__ __forceinline__ float wave_max(float v) {
    v = fmaxf(v, __shfl_xor(v, 1)); v = fmaxf(v, __shfl_xor(v, 2)); v = fmaxf(v, __shfl_xor(v, 4)); v = fmaxf(v, __shfl_xor(v, 8)); v = fmaxf(v, __shfl_xor(v, 16)); v = fmaxf(v, __shfl_xor(v, 32)); return v;
}
__device__ __forceinline__ float dpp_shr1(float v) { return __int_as_float(__builtin_amdgcn_update_dpp(0, __float_as_int(v), 0x111, 0xf, 0xf, true)); }
__device__ __forceinline__ f32x4 dpp_shr1_4(f32x4 v) { f32x4 o; o[0] = dpp_shr1(v[0]); o[1] = dpp_shr1(v[1]); o[2] = dpp_shr1(v[2]); o[3] = dpp_shr1(v[3]); return o; }

constexpr int BM = 256, BK = 64, HALF = 128, HTB = HALF * BK * 2, NXCD = 8, WGM = 8;
__device__ __forceinline__ int lds_byte(int r, int c) { const int st = (r >> 4) * 2 + (c >> 5), rr = r & 15, cc = c & 31, ob = rr * 64 + cc * 2; return st * 1024 + (ob ^ (((ob >> 9) & 1) << 5)); }
__device__ __forceinline__ void stage_rc(int b, int& R, int& C) { const int st = b / 1024, sb = b % 1024, swz = sb ^ (((sb >> 9) & 1) << 5); R = (st >> 1) * 16 + swz / 64; C = (st & 1) * 32 + (swz % 64) / 2; }
__device__ __forceinline__ int perm32(int rho) { const int n = rho >> 4, i = rho & 15; return 8 * (i >> 2) + 4 * n + (i & 3); }

struct Unit { int pm, pn; };
struct Gemm { const bf16_t* A; const bf16_t* Bt; int M, N, K; };
struct StaticOrder {
    int nM, nN, nwg, G, c;
    __device__ void init(int M, int N, int G_, int c_) { nM = M / BM; nN = N / BM; nwg = nM * nN; G = G_; c = c_; }
    __device__ bool next(int i, Unit& u) const {
        const long L = (long)i * G + c; if (L >= nwg || c < 0) return false;
        int wgid = (int)L; { const int q = nwg / NXCD, r = nwg % NXCD, xcd = wgid % NXCD, off = wgid / NXCD; wgid = (xcd < r ? xcd * (q + 1) : r * (q + 1) + (xcd - r) * q) + off; }
        const int nig = WGM * nN, gid = wgid / nig, fm = gid * WGM, gsz = (nM - fm) < WGM ? (nM - fm) : WGM;
        u.pm = fm + ((wgid % nig) % gsz); u.pn = (wgid % nig) / gsz; return true;
    }
};

struct OneUnit { Unit u; __device__ bool next(int i, Unit& o) const { if (i != 0) return false; o = u; return true; } };
template <class Epi, class Sched>
__device__ __forceinline__ void gemm_phase(LAS unsigned char* lds, const Gemm g, const Sched& S, const Epi& E) {
    const int tid = ltid(), wid = __builtin_amdgcn_readfirstlane(tid >> 6), lane = tid & 63, wr = wid >> 2, wc = wid & 3, fr = lane & 15, fq = lane >> 4;
    const int K = g.K, nt = K / BK;
    unsigned voffA[2], voffB[2];
#pragma unroll
    for (int i = 0; i < 2; ++i) { int R, C; stage_rc(tid * 16 + i * 8192, R, C); const int Rb = Epi::PERM ? ((R & ~31) + perm32(R & 31)) : R;
        const int Ra = Epi::PERMA ? (128 * (R >> 6) + 8 * (R & 15) + ((R >> 4) & 3)) : R;
        voffA[i] = (unsigned)(Ra * K + C) * 2u; voffB[i] = (unsigned)(Rb * K + C) * 2u; }
    const size_t kstep = (size_t)(BK * 2);
    const size_t hstep = (size_t)HALF * K * 2;
    const size_t hstepA = Epi::PERMA ? (size_t)4 * K * 2 : hstep;
    const size_t tstep = 2 * hstep;
    const unsigned ldsw = (unsigned)wid * 1024u;
    const int aoff = lds_byte(wr * 64 + fr, fq * 8), boff = lds_byte(wc * 32 + fr, fq * 8);
#define PG8_SA(b, h) (((b) * 2 + (h)) * HTB)
#define PG8_SB(b, h) ((4 + (b) * 2 + (h)) * HTB)
#define PG8_STAGE(bufoff, gbase, voff) do { _Pragma("unroll") for (int _i = 0; _i < 2; ++_i) \
        __builtin_amdgcn_global_load_lds((const unsigned*)((const char*)(gbase) + (voff)[_i]), (LAS unsigned*)(lds + (bufoff) + ldsw + _i * 8192), 16, 0, 0); } while (0)
#define PG8_LDA(dst, b, h) do { _Pragma("unroll") for (int m = 0; m < 4; ++m) _Pragma("unroll") for (int k = 0; k < 2; ++k) dst[m][k] = *(const LAS bf16x8*)(lds + PG8_SA(b, h) + aoff + m * 2048 + k * 1024); } while (0)
#define PG8_LDB(dst, b, h) do { _Pragma("unroll") for (int n = 0; n < 2; ++n) _Pragma("unroll") for (int k = 0; k < 2; ++k) dst[n][k] = *(const LAS bf16x8*)(lds + PG8_SB(b, h) + boff + n * 2048 + k * 1024); } while (0)
#define PG8_MMA(ai, bj, At, Bt) do { __builtin_amdgcn_s_setprio(1); _Pragma("unroll") for (int m = 0; m < 4; ++m) _Pragma("unroll") for (int n = 0; n < 2; ++n) _Pragma("unroll") for (int k = 0; k < 2; ++k) \
        acc[ai][bj][m][n] = __builtin_amdgcn_mfma_f32_16x16x32_bf16(Bt[n][k], At[m][k], acc[ai][bj][m][n], 0, 0, 0); __builtin_amdgcn_s_setprio(0); } while (0)
#define PG8_WAIT_V(n) asm volatile("s_waitcnt vmcnt(" #n ")" ::: "memory")
#define PG8_WAIT_L(n) asm volatile("s_waitcnt lgkmcnt(" #n ")" ::: "memory")
#define PG8_BAR __builtin_amdgcn_s_barrier()
#define PG8_SCHED __builtin_amdgcn_sched_barrier(0)
    Unit cur, nxt; int ui = 0;
    if (!S.next(0, cur)) return;
    E.pin();
    asm volatile("s_waitcnt lgkmcnt(0)" ::: "memory");
    f32x4 acc[2][2][4][2];
#pragma unroll
    for (int a = 0; a < 2; ++a)
#pragma unroll
        for (int b = 0; b < 2; ++b)
#pragma unroll
            for (int m = 0; m < 4; ++m)
#pragma unroll
                for (int n = 0; n < 2; ++n) acc[a][b][m][n] = (f32x4){0.f, 0.f, 0.f, 0.f};
    bf16x8 At[4][2], B0[2][2], B1[2][2];
    const char* cA = (const char*)g.A + (size_t)cur.pm * tstep; const char* cB = (const char*)g.Bt + (size_t)cur.pn * tstep;
    PG8_STAGE(PG8_SB(0, 0), cB, voffB); PG8_STAGE(PG8_SA(0, 0), cA, voffA); PG8_STAGE(PG8_SB(0, 1), cB + hstep, voffB); PG8_STAGE(PG8_SA(0, 1), cA + hstepA, voffA);
    if (wr == 1) PG8_BAR;
    PG8_WAIT_V(4); PG8_BAR;
    PG8_STAGE(PG8_SB(1, 0), cB + kstep, voffB); PG8_STAGE(PG8_SA(1, 0), cA + kstep, voffA); PG8_STAGE(PG8_SB(1, 1), cB + hstep + kstep, voffB);
    PG8_WAIT_V(6); PG8_BAR;
    for (;;) {
        const bool has_next = S.next(ui + 1, nxt);
        const char* nA = has_next ? (const char*)g.A + (size_t)nxt.pm * tstep : cA; const char* nB = has_next ? (const char*)g.Bt + (size_t)nxt.pn * tstep : cB;
        for (int t = 0; t < nt; t += 2) {
            const bool last = (t == nt - 2);
            const char* a1 = cA + (size_t)(t + 1) * kstep;
            const char* a2 = last ? nA : cA + (size_t)(t + 2) * kstep; const char* b2 = last ? nB : cB + (size_t)(t + 2) * kstep;
            const char* a3 = a2 + kstep; const char* b3 = b2 + kstep;
            if constexpr (Epi::MID) { if (t == 8 || t == 12) E.mid(acc, cur, t, wr, wc, fr, fq); }
            PG8_LDB(B0, 0, 0); PG8_SCHED; PG8_LDA(At, 0, 0); PG8_STAGE(PG8_SA(1, 1), a1 + hstepA, voffA);
            PG8_WAIT_L(8); PG8_BAR; PG8_WAIT_L(0); PG8_MMA(0, 0, At, B0); PG8_BAR; PG8_SCHED;
            PG8_LDB(B1, 0, 1); PG8_STAGE(PG8_SB(0, 0), b2, voffB);
            PG8_BAR; PG8_WAIT_L(0); PG8_MMA(0, 1, At, B1); PG8_BAR;
            PG8_LDA(At, 0, 1); PG8_STAGE(PG8_SA(0, 0), a2, voffA);
            PG8_BAR; PG8_WAIT_L(0); PG8_MMA(1, 0, At, B0); PG8_BAR; PG8_SCHED;
            PG8_STAGE(PG8_SB(0, 1), b2 + hstep, voffB);
            PG8_WAIT_V(6); PG8_BAR; PG8_MMA(1, 1, At, B1); PG8_BAR;
            PG8_LDB(B0, 1, 0); PG8_SCHED; PG8_LDA(At, 1, 0); PG8_STAGE(PG8_SA(0, 1), a2 + hstepA, voffA);
            PG8_WAIT_L(8); PG8_BAR; PG8_WAIT_L(0); PG8_MMA(0, 0, At, B0); PG8_BAR; PG8_SCHED;
            PG8_LDB(B1, 1, 1); PG8_STAGE(PG8_SB(1, 0), b3, voffB);
            PG8_BAR; PG8_WAIT_L(0); PG8_MMA(0, 1, At, B1); PG8_BAR;
            PG8_LDA(At, 1, 1); PG8_STAGE(PG8_SA(1, 0), a3, voffA);
            PG8_BAR; PG8_WAIT_L(0); PG8_MMA(1, 0, At, B0); PG8_BAR; PG8_SCHED;
            PG8_STAGE(PG8_SB(1, 1), b3 + hstep, voffB);
            PG8_WAIT_V(6); PG8_BAR; PG8_MMA(1, 1, At, B1); PG8_BAR;
        }
        if constexpr (!Epi::DRAIN) E(acc, cur, wr, wc, fr, fq);
        if (!has_next) break;
#pragma unroll
        for (int a = 0; a < 2; ++a)
#pragma unroll
            for (int b = 0; b < 2; ++b)
#pragma unroll
                for (int m = 0; m < 4; ++m)
#pragma unroll
                    for (int n = 0; n < 2; ++n) acc[a][b][m][n] = (f32x4){0.f, 0.f, 0.f, 0.f};
        cur = nxt; cA = nA; cB = nB; ++ui;
    }
    PG8_WAIT_V(0);
    if (wr == 0) PG8_BAR;
    PG8_BAR;
    if constexpr (Epi::DRAIN) E(acc, cur, wr, wc, fr, fq);
#undef PG8_SA
#undef PG8_SB
#undef PG8_STAGE
#undef PG8_LDA
#undef PG8_LDB
#undef PG8_MMA
#undef PG8_WAIT_V
#undef PG8_WAIT_L
#undef PG8_BAR
#undef PG8_SCHED
}

typedef f32x4 Acc[2][2][4][2];

struct EpiG1 {
    static constexpr bool PERM = true, PERMA = false, MID = false, DRAIN = false;
    bf16_t* UV; float* BP; bf16_t* Q; bf16_t* GATES; const float* bgate;
    __device__ __forceinline__ void pin() const { asm volatile("" :: "s"(UV), "s"(BP), "s"(Q), "s"(GATES), "s"(bgate)); }
    __device__ __forceinline__ void operator()(const Acc& acc, const Unit& u, int wr, int wc, int fr, int fq) const {
        const int row0 = u.pm * BM + wr * 64 + fr, colw = wc * 32 + 8 * fq;
        if (u.pn < 4) {
#pragma unroll
            for (int ai = 0; ai < 2; ++ai)
#pragma unroll
                for (int m = 0; m < 4; ++m) { bf16_t* rowp = UV + (size_t)(row0 + ai * HALF + m * 16) * 1024 + u.pn * 256 + colw;
#pragma unroll
                    for (int bj = 0; bj < 2; ++bj) *(u32x4*)(rowp + bj * HALF) = pack8(gelu4(acc[ai][bj][m][0]), gelu4(acc[ai][bj][m][1])); }
        } else if (u.pn == 4) {
#pragma unroll
            for (int ai = 0; ai < 2; ++ai)
#pragma unroll
                for (int m = 0; m < 4; ++m) { float* rowp = BP + (size_t)(row0 + ai * HALF + m * 16) * 256 + colw;
#pragma unroll
                    for (int bj = 0; bj < 2; ++bj) { *(f32x4*)(rowp + bj * HALF) = acc[ai][bj][m][0]; *(f32x4*)(rowp + bj * HALF + 4) = acc[ai][bj][m][1]; } }
        } else if (u.pn == 5) {
#pragma unroll
            for (int ai = 0; ai < 2; ++ai)
#pragma unroll
                for (int m = 0; m < 4; ++m) { bf16_t* rowp = Q + (size_t)(row0 + ai * HALF + m * 16) * 256 + colw;
#pragma unroll
                    for (int bj = 0; bj < 2; ++bj) *(u32x4*)(rowp + bj * HALF) = pack8(acc[ai][bj][m][0] * 0.125f, acc[ai][bj][m][1] * 0.125f); }
        } else {
            const int gc0 = (u.pn - 6) * 256 + colw;
            f32x4 bv[2][2];
#pragma unroll
            for (int bj = 0; bj < 2; ++bj)
#pragma unroll
                for (int n = 0; n < 2; ++n) bv[bj][n] = *(const f32x4*)(bgate + gc0 + bj * HALF + 4 * n);
#pragma unroll
            for (int ai = 0; ai < 2; ++ai)
#pragma unroll
                for (int m = 0; m < 4; ++m) { bf16_t* rowp = GATES + (size_t)(row0 + ai * HALF + m * 16) * 3072 + gc0;
#pragma unroll
                    for (int bj = 0; bj < 2; ++bj) { f32x4 v0 = acc[ai][bj][m][0] + bv[bj][0], v1 = acc[ai][bj][m][1] + bv[bj][1];
#pragma unroll
                        for (int j = 0; j < 4; ++j) { v0[j] = sigm1(v0[j]); v1[j] = sigm1(v1[j]); }
                        *(u32x4*)(rowp + bj * HALF) = pack8(v0, v1); } }
        }
    }
};

struct EpiKV {
    static constexpr bool PERM = false, PERMA = false, MID = false, DRAIN = false;
    float* outK; float* outV; bf16_t* KB; bf16_t* VT;
    __device__ __forceinline__ void pin() const { asm volatile("" :: "s"(outK), "s"(outV), "s"(KB), "s"(VT)); }
    __device__ __forceinline__ void operator()(const Acc& acc, const Unit& u, int wr, int wc, int fr, int fq) const {
#pragma unroll
        for (int ai = 0; ai < 2; ++ai)
#pragma unroll
            for (int m = 0; m < 4; ++m) { const int r = u.pm * BM + ai * HALF + wr * 64 + m * 16 + fr;
#pragma unroll
                for (int bj = 0; bj < 2; ++bj)
#pragma unroll
                    for (int n = 0; n < 2; ++n) { const int c = bj * HALF + wc * 32 + n * 16 + 4 * fq; const f32x4 v = acc[ai][bj][m][n];
                        if (u.pn == 0) { *(f32x4*)(outK + (size_t)r * 256 + c) = v; *(u32x2*)(KB + (size_t)r * 256 + c) = pack4(v); }
                        else { *(f32x4*)(outV + (size_t)r * 256 + c) = v; const int b = r >> 8, mm = r & 255, h = c >> 6, d = c & 63;
                            bf16_t* vt = VT + ((size_t)((b * 4 + h) * 64 + d)) * 256 + mm;
                            vt[0] = f2bf(v[0]); vt[256] = f2bf(v[1]); vt[512] = f2bf(v[2]); vt[768] = f2bf(v[3]); } } }
    }
};

struct EpiG2 {
    static constexpr bool PERM = true, PERMA = false, MID = true, DRAIN = false;
    const bf16_t* GATES; bf16_t* MERGED;
    __device__ __forceinline__ void pin() const { asm volatile("" :: "s"(GATES), "s"(MERGED)); }
    __device__ __forceinline__ void mid(Acc& acc, const Unit& u, int t, int wr, int wc, int fr, int fq) const {
        int row0 = u.pm * BM + wr * 64 + fr; asm volatile("" : "+v"(row0));
        const int col0 = u.pn * 256 + wc * 32 + 8 * fq;
        const int nb = (t == 8) ? 0 : 1024;
#pragma unroll
        for (int ai = 0; ai < 2; ++ai)
#pragma unroll
            for (int m = 0; m < 4; ++m) { const bf16_t* gp = GATES + (size_t)(row0 + ai * HALF + m * 16) * 3072 + nb + col0;
#pragma unroll
                for (int bj = 0; bj < 2; ++bj) { const u32x4 wn = *(const u32x4*)(gp + bj * HALF), wd = *(const u32x4*)(gp + 1024 + bj * HALF);
                    f32x4 n0, n1, d0, d1; unpack8(wn, n0, n1); unpack8(wd, d0, d1);
#pragma unroll
                    for (int j = 0; j < 4; ++j) { acc[ai][bj][m][0][j] *= n0[j] * __builtin_amdgcn_rcpf(d0[j]); acc[ai][bj][m][1][j] *= n1[j] * __builtin_amdgcn_rcpf(d1[j]); } }
                asm volatile("" ::: "memory"); }
    }
    __device__ __forceinline__ void operator()(const Acc& acc, const Unit& u, int wr, int wc, int fr, int fq) const {
        const int row0 = u.pm * BM + wr * 64 + fr, col0 = u.pn * 256 + wc * 32 + 8 * fq;
#pragma unroll
        for (int ai = 0; ai < 2; ++ai)
#pragma unroll
            for (int m = 0; m < 4; ++m) { const size_t r = (size_t)(row0 + ai * HALF + m * 16);
#pragma unroll
                for (int bj = 0; bj < 2; ++bj) { const u32x4 wg = *(const u32x4*)(GATES + r * 3072 + 2048 + col0 + bj * HALF); f32x4 g0, g1; unpack8(wg, g0, g1);
                    *(u32x4*)(MERGED + r * 1024 + col0 + bj * HALF) = pack8(acc[ai][bj][m][0] * g0, acc[ai][bj][m][1] * g1); }
                asm volatile("" ::: "memory"); }
    }
};

struct EpiSS {
    static constexpr bool PERM = false, PERMA = false, MID = false, DRAIN = false;
    float* C; float* SS;
    __device__ __forceinline__ void pin() const { asm volatile("" :: "s"(C), "s"(SS)); }
    __device__ __forceinline__ void operator()(const Acc& acc, const Unit& u, int wr, int wc, int fr, int fq) const {
        const int row0 = u.pm * BM + wr * 64 + fr, col0 = u.pn * BM + wc * 32 + 4 * fq;
#pragma unroll
        for (int ai = 0; ai < 2; ++ai)
#pragma unroll
            for (int m = 0; m < 4; ++m) { const size_t r = (size_t)(row0 + ai * HALF + m * 16); float* rowp = C + r * 1024 + col0; float s = 0.f;
#pragma unroll
                for (int bj = 0; bj < 2; ++bj)
#pragma unroll
                    for (int n = 0; n < 2; ++n) { const f32x4 v = acc[ai][bj][m][n]; *(f32x4*)(rowp + bj * HALF + n * 16) = v; s += (v[0] * v[0] + v[1] * v[1]) + (v[2] * v[2] + v[3] * v[3]); }
                s += __shfl_xor(s, 16); s += __shfl_xor(s, 32);
                if (fq == 0) SS[r * 16 + u.pn * 4 + wc] = s; }
    }
};

struct EpiG4 {
    static constexpr bool PERM = true, PERMA = true, MID = false, DRAIN = false;
    bf16_t* Y; float* GRAW; float* URAW; const float* cw; const float* cb; const float* sconv; float* outCP; float* outCS;
    __device__ __forceinline__ void pin() const { asm volatile("" :: "s"(Y), "s"(GRAW), "s"(URAW), "s"(cw), "s"(cb), "s"(sconv), "s"(outCP), "s"(outCS)); }
    __device__ __forceinline__ void operator()(const Acc& acc, const Unit& u, int wr, int wc, int fr, int fq) const {
#pragma unroll
        for (int n = 0; n < 2; ++n) {
            const int ch = u.pn * 128 + wc * 32 + 8 * fq + 4 * n;
            const f32x4 w0 = *(const f32x4*)(cw + ch), w1 = *(const f32x4*)(cw + DFF + ch), w2 = *(const f32x4*)(cw + 2 * DFF + ch), bb = *(const f32x4*)(cb + ch);
            if (u.pm < 64) {
                const int seg = 2 * u.pm + wr; const size_t tok0 = (size_t)seg * 128 + 8 * fr;
                f32x4 p2 = dpp_shr1_4(acc[1][0][2][n]), p1 = dpp_shr1_4(acc[1][0][3][n]);
#pragma unroll
                for (int j8 = 0; j8 < 8; ++j8) { const f32x4 gv = acc[j8 >> 2][0][j8 & 3][n], uv = acc[j8 >> 2][1][j8 & 3][n];
                    const f32x4 c = bb + w0 * p2 + w1 * p1 + w2 * gv;
                    if (!(fr == 0 && j8 < 2)) *(u32x2*)(Y + (tok0 + j8) * DFF + ch) = pack4(gelu4(c) * uv);
                    p2 = p1; p1 = gv; }
                if (fr == 0) {
                    *(f32x4*)(GRAW + (size_t)(seg * 4 + 2) * DFF + ch) = acc[0][0][0][n]; *(f32x4*)(GRAW + (size_t)(seg * 4 + 3) * DFF + ch) = acc[0][0][1][n];
                    *(f32x4*)(URAW + (size_t)(seg * 2 + 0) * DFF + ch) = acc[0][1][0][n]; *(f32x4*)(URAW + (size_t)(seg * 2 + 1) * DFF + ch) = acc[0][1][1][n];
                }
                if (fr == 15) {
                    *(f32x4*)(GRAW + (size_t)(seg * 4 + 0) * DFF + ch) = acc[1][0][2][n]; *(f32x4*)(GRAW + (size_t)(seg * 4 + 1) * DFF + ch) = acc[1][0][3][n];
                    if ((seg & 15) == 15) { const int b = seg >> 4; *(f32x4*)(outCP + (size_t)(b * 2 + 0) * DFF + ch) = acc[1][0][2][n]; *(f32x4*)(outCP + (size_t)(b * 2 + 1) * DFF + ch) = acc[1][0][3][n]; }
                }
            } else {
                const int si0 = 256 * (u.pm - 64) + 128 * wr + 8 * fr;
#pragma unroll
                for (int hh = 0; hh < 2; ++hh) { const int b = (si0 >> 2) + hh;
                    f32x4 p2 = *(const f32x4*)(sconv + (size_t)(b * 2 + 0) * DFF + ch), p1 = *(const f32x4*)(sconv + (size_t)(b * 2 + 1) * DFF + ch);
#pragma unroll
                    for (int t = 0; t < 4; ++t) { const f32x4 gv = acc[hh][0][t][n], uv = acc[hh][1][t][n];
                        const f32x4 c = bb + w0 * p2 + w1 * p1 + w2 * gv;
                        *(u32x2*)(Y + (size_t)(NPROMPT + b * 4 + t) * DFF + ch) = pack4(gelu4(c) * uv);
                        p2 = p1; p1 = gv; }
                    *(f32x4*)(outCS + (size_t)(b * 2 + 0) * DFF + ch) = acc[hh][0][2][n]; *(f32x4*)(outCS + (size_t)(b * 2 + 1) * DFF + ch) = acc[hh][0][3][n]; }
            }
        }
    }
};

__device__ __forceinline__ void prep_tile(const float* src, int ldsrc, int k0, int n0, bf16_t* dst, int lddst, int dstrow0, int dstk0, LAS float* T) {
    const int tid = ltid();
#pragma unroll
    for (int i = 0; i < 2; ++i) { const int idx = tid + 512 * i, kk = idx >> 4, c4 = (idx & 15) * 4;
        const f32x4 v = *(const f32x4*)(src + (size_t)(k0 + kk) * ldsrc + n0 + c4);
        T[kk * 65 + c4] = v[0]; T[kk * 65 + c4 + 1] = v[1]; T[kk * 65 + c4 + 2] = v[2]; T[kk * 65 + c4 + 3] = v[3]; }
    __syncthreads();
    { const int nn = tid >> 3, kc = (tid & 7) * 8; f32x4 a, b;
#pragma unroll
      for (int i = 0; i < 4; ++i) { a[i] = T[(kc + i) * 65 + nn]; b[i] = T[(kc + 4 + i) * 65 + nn]; }
      *(u32x4*)(dst + (size_t)(dstrow0 + nn) * lddst + dstk0 + kc) = pack8(a, b); }
    __syncthreads();
}
__device__ __forceinline__ void prep_wpb(const float* wp, const float* ps, const float* wb, int g, int n0, bf16_t* WbrT, LAS float* T) {
    const int tid = ltid(); LAS float* TA = T; LAS float* TB = T + 64 * 65;
#pragma unroll
    for (int i = 0; i < 2; ++i) { const int idx = tid + 512 * i, kk = idx >> 4, c4 = (idx & 15) * 4;
        const f32x4 va = *(const f32x4*)(wp + (size_t)(g * 64 + kk) * 64 + c4), sc = *(const f32x4*)(ps + g * 64 + c4);
        const f32x4 vb = *(const f32x4*)(wb + (size_t)(g * 64 + kk) * 1024 + n0 + c4);
#pragma unroll
        for (int j = 0; j < 4; ++j) { TA[kk * 65 + c4 + j] = va[j] * sc[j]; TB[kk * 65 + c4 + j] = vb[j]; } }
    __syncthreads();
    { const int nn = tid >> 3, dc = (tid & 7) * 8; f32x4 a = {0.f, 0.f, 0.f, 0.f}, b = {0.f, 0.f, 0.f, 0.f};
      for (int e = 0; e < 64; ++e) { const float bv = TB[e * 65 + nn];
#pragma unroll
          for (int i = 0; i < 4; ++i) { a[i] += TA[(dc + i) * 65 + e] * bv; b[i] += TA[(dc + 4 + i) * 65 + e] * bv; } }
      *(u32x4*)(WbrT + (size_t)(n0 + nn) * 1024 + 512 + g * 64 + dc) = pack8(a, b); }
    __syncthreads();
}
__device__ __forceinline__ void rms_row_to_bf16(const float* xrow, const float* gain, bf16_t* dst, int lane) {
    f32x4 v[4]; float s = 0.f;
#pragma unroll
    for (int i = 0; i < 2; ++i) { v[2 * i] = *(const f32x4*)(xrow + lane * 8 + 512 * i); v[2 * i + 1] = *(const f32x4*)(xrow + lane * 8 + 512 * i + 4); }
#pragma unroll
    for (int i = 0; i < 4; ++i) s += (v[i][0] * v[i][0] + v[i][1] * v[i][1]) + (v[i][2] * v[i][2] + v[i][3] * v[i][3]);
    s = wave_sum(s); const float inv = rsqrtf(s * (1.0f / 1024.0f) + EPSV);
#pragma unroll
    for (int i = 0; i < 2; ++i) { const f32x4 g0 = *(const f32x4*)(gain + lane * 8 + 512 * i), g1 = *(const f32x4*)(gain + lane * 8 + 512 * i + 4);
        *(u32x4*)(dst + lane * 8 + 512 * i) = pack8(v[2 * i] * inv * g0, v[2 * i + 1] * inv * g1); }
}

__device__ __forceinline__ void phase_prep(KP p, LAS unsigned char* lds) {
    unsigned char* ws = p->ws; LAS float* T = (LAS float*)lds;
    bf16_t* WinT = (bf16_t*)(ws + WS_WIN); bf16_t* WkvT = (bf16_t*)(ws + WS_WKV); bf16_t* WbrT = (bf16_t*)(ws + WS_WBR); bf16_t* WoutT = (bf16_t*)(ws + WS_WOUT);
    bf16_t* WupT = (bf16_t*)(ws + WS_WUP); bf16_t* WdownT = (bf16_t*)(ws + WS_WDOWN); bf16_t* WsT = (bf16_t*)(ws + WS_WST);
    const int G = gridDim.x, tid = ltid(), lane = tid & 63, wid = tid >> 6;
    for (int row = blockIdx.x * 8 + wid; row < MT + 2048; row += G * 8) {
        if (row < MT) { const float* xr = row < NPROMPT ? p->in[0] + (size_t)row * 1024 : p->in[1] + (size_t)(row - NPROMPT) * 1024;
            rms_row_to_bf16(xr, p->in[7], (bf16_t*)(ws + WS_R1) + (size_t)row * 1024, lane); }
        else { const int r = row - MT; rms_row_to_bf16(p->in[2] + (size_t)r * 1024, p->in[19], (bf16_t*)(ws + WS_MEMN) + (size_t)r * 1024, lane); }
    }
    for (int i = blockIdx.x * 512 + tid; i < 4 * 128 * 128; i += G * 512) { const int t = (i >> 7) & 127, s = i & 127; WsT[i] = (s <= t) ? f2bf(p->in[15][i]) : (bf16_t)0; }
    constexpr int J0 = 16 * 72, J1 = J0 + 16 * 8, J2 = J1 + 16 * 16, J3 = J2 + 16 * 88, J4 = J3 + 44 * 16, J5 = J4 + 8 * 16, J6 = J5 + 4 * 16, J7 = J6 + 4 * 16;
    for (int job = blockIdx.x; job < J7; job += G) {
        if (job < J0) { const int kt = job / 72, nt = job % 72; prep_tile(p->in[11], DIN, kt * 64, nt * 64, WinT, 1024, nt * 64, kt * 64, T); }
        else if (job < J1) { const int j = job - J0, kt = j / 8, nt = j % 8; prep_tile(p->in[20], 512, kt * 64, nt * 64, WkvT, 1024, nt * 64, kt * 64, T); }
        else if (job < J2) { const int j = job - J1, kt = j / 16, nt = j % 16; prep_tile(p->in[24], 1024, kt * 64, nt * 64, WoutT, 1024, nt * 64, kt * 64, T); }
        else if (job < J3) { const int j = job - J2, kt = j / 88, nt = j % 88; const int n0 = nt * 64; const int cc = n0 < DFF ? n0 : n0 - DFF;
            const int drow = (cc >> 7) * 256 + (n0 < DFF ? 0 : 128) + (cc & 127); prep_tile(p->in[25], NUP, kt * 64, n0, WupT, 1024, drow, kt * 64, T); }
        else if (job < J4) { const int j = job - J3, kt = j / 16, nt = j % 16; prep_tile(p->in[28], 1024, kt * 64, nt * 64, WdownT, DFF, nt * 64, kt * 64, T); }
        else if (job < J5) { const int j = job - J4, kt = j / 16, nt = j % 16; prep_tile(p->in[21], 1024, kt * 64, nt * 64, WbrT, 1024, nt * 64, kt * 64, T); }
        else if (job < J6) { const int j = job - J5, kt = j / 16, nt = j % 16; prep_tile(p->in[23], 1024, kt * 64, nt * 64, WbrT, 1024, nt * 64, 768 + kt * 64, T); }
        else { const int j = job - J6, g = j / 16, nt = j % 16; prep_wpb(p->in[17], p->in[18], p->in[22], g, nt * 64, WbrT, T); }
    }
}

__device__ __forceinline__ void mixA_prompt(KP p, int item, LAS unsigned char* lds) {
    const int tid = ltid(), lane = tid & 63, wid = tid >> 6, fr = lane & 15, fq = lane >> 4;
    const int g = item & 3, tok0 = (item >> 2) * 128;
    const bf16_t* UV = (const bf16_t*)(p->ws + WS_R2); bf16_t* ABC = (bf16_t*)(p->ws + WS_R1); const bf16_t* WsT = (const bf16_t*)(p->ws + WS_WST);
    LAS bf16_t* vnT = (LAS bf16_t*)lds;
    { const int row = tid >> 2, part = tid & 3; const bf16_t* vrow = UV + (size_t)(tok0 + row) * 1024 + 512;
      float s = 0.f, q = 0.f;
#pragma unroll 4
      for (int i = 0; i < 16; ++i) { const u32x4 w = *(const u32x4*)(vrow + part * 128 + i * 8); f32x4 a, b; unpack8(w, a, b);
          s += (a[0] + a[1]) + (a[2] + a[3]) + (b[0] + b[1]) + (b[2] + b[3]);
          q += (a[0] * a[0] + a[1] * a[1]) + (a[2] * a[2] + a[3] * a[3]) + (b[0] * b[0] + b[1] * b[1]) + (b[2] * b[2] + b[3] * b[3]); }
      s += __shfl_xor(s, 1); s += __shfl_xor(s, 2); q += __shfl_xor(q, 1); q += __shfl_xor(q, 2);
      const float mean = s * (1.0f / 512.0f), var = fmaxf(q * (1.0f / 512.0f) - mean * mean, 0.f), rstd = rsqrtf(var + EPSV);
#pragma unroll
      for (int i = 0; i < 4; ++i) { const int d0 = part * 32 + i * 8; const u32x4 w = *(const u32x4*)(vrow + g * 128 + d0); f32x4 a, b; unpack8(w, a, b);
          const f32x4 g0 = *(const f32x4*)(p->in[13] + g * 128 + d0), g1 = *(const f32x4*)(p->in[13] + g * 128 + d0 + 4);
          const f32x4 b0 = *(const f32x4*)(p->in[14] + g * 128 + d0), b1 = *(const f32x4*)(p->in[14] + g * 128 + d0 + 4);
          a = (a - mean) * rstd * g0 + b0; b = (b - mean) * rstd * g1 + b1;
#pragma unroll
          for (int j = 0; j < 4; ++j) { vnT[(d0 + j) * 136 + row] = f2bf(a[j]); vnT[(d0 + 4 + j) * 136 + row] = f2bf(b[j]); } } }
    __syncthreads();
    { f32x4 acc[8];
#pragma unroll
      for (int nb = 0; nb < 8; ++nb) acc[nb] = (f32x4){0.f, 0.f, 0.f, 0.f};
      const int nks = (wid >> 1) + 1;
      for (int ks = 0; ks < nks; ++ks) {
          const bf16x8 wf = *(const bf16x8*)(WsT + (size_t)g * 16384 + (16 * wid + fr) * 128 + ks * 32 + fq * 8);
#pragma unroll
          for (int nb = 0; nb < 8; ++nb) { const bf16x8 vf = *(const LAS bf16x8*)(vnT + (nb * 16 + fr) * 136 + ks * 32 + fq * 8);
              acc[nb] = __builtin_amdgcn_mfma_f32_16x16x32_bf16(vf, wf, acc[nb], 0, 0, 0); } }
      const int t = 16 * wid + fr; const size_t tok = (size_t)tok0 + t; const float bias = p->in[16][g * 128 + t];
#pragma unroll
      for (int nb = 0; nb < 8; ++nb) { const int ch = g * 128 + nb * 16 + fq * 4; const f32x4 uu = unpack4(*(const u32x2*)(UV + tok * 1024 + ch));
          *(u32x2*)(ABC + tok * 1024 + ch) = pack4(uu * (acc[nb] + bias)); } }
    __syncthreads();
}

__device__ __forceinline__ void mixC_prompt(KP p, int item) {
    const int tid = ltid(), lane = tid & 63, wid = tid >> 6, fr = lane & 15, fq = lane >> 4;
    const int h = item & 3, bc = item >> 2, b = bc >> 4, tok0 = bc * 128;
    const bf16_t* Q = (const bf16_t*)(p->ws + WS_Q); const bf16_t* KB = (const bf16_t*)(p->ws + WS_KB); const bf16_t* VT = (const bf16_t*)(p->ws + WS_VT); bf16_t* ABC = (bf16_t*)(p->ws + WS_R1);
    const size_t qrow = (size_t)tok0 + 16 * wid + fr;
    const bf16x8 q0 = *(const bf16x8*)(Q + qrow * 256 + h * 64 + fq * 8), q1 = *(const bf16x8*)(Q + qrow * 256 + h * 64 + 32 + fq * 8);
    f32x4 s[16];
#pragma unroll
    for (int kb = 0; kb < 16; ++kb) { const bf16_t* kp = KB + (size_t)(b * 256 + kb * 16 + fr) * 256 + h * 64 + fq * 8;
        const bf16x8 k0 = *(const bf16x8*)kp, k1 = *(const bf16x8*)(kp + 32);
        s[kb] = __builtin_amdgcn_mfma_f32_16x16x32_bf16(k0, q0, (f32x4){0.f, 0.f, 0.f, 0.f}, 0, 0, 0);
        s[kb] = __builtin_amdgcn_mfma_f32_16x16x32_bf16(k1, q1, s[kb], 0, 0, 0); }
    float mx = -3.0e38f;
#pragma unroll
    for (int kb = 0; kb < 16; ++kb) mx = fmaxf(mx, fmaxf(fmaxf(s[kb][0], s[kb][1]), fmaxf(s[kb][2], s[kb][3])));
    mx = fmaxf(mx, __shfl_xor(mx, 16)); mx = fmaxf(mx, __shfl_xor(mx, 32));
    float sum = 0.f;
#pragma unroll
    for (int kb = 0; kb < 16; ++kb) {
#pragma unroll
        for (int j = 0; j < 4; ++j) { const float e = __builtin_amdgcn_exp2f((s[kb][j] - mx) * 1.442695041f); s[kb][j] = e; sum += e; } }
    sum += __shfl_xor(sum, 16); sum += __shfl_xor(sum, 32);
    f32x4 o[4];
#pragma unroll
    for (int db = 0; db < 4; ++db) o[db] = (f32x4){0.f, 0.f, 0.f, 0.f};
#pragma unroll
    for (int kk = 0; kk < 8; ++kk) { const u32x4 pw = pack8(s[2 * kk], s[2 * kk + 1]); const bf16x8 pf = __builtin_bit_cast(bf16x8, pw);
#pragma unroll
        for (int db = 0; db < 4; ++db) { const bf16_t* vp = VT + ((size_t)((b * 4 + h) * 64 + db * 16 + fr)) * 256 + kk * 32 + fq * 4;
            const u32x2 v0 = *(const u32x2*)vp, v1 = *(const u32x2*)(vp + 16); u32x4 vw; vw[0] = v0[0]; vw[1] = v0[1]; vw[2] = v1[0]; vw[3] = v1[1];
            o[db] = __builtin_amdgcn_mfma_f32_16x16x32_bf16(__builtin_bit_cast(bf16x8, vw), pf, o[db], 0, 0, 0); } }
    const float inv = 1.0f / sum;
#pragma unroll
    for (int db = 0; db < 4; ++db) *(u32x2*)(ABC + qrow * 1024 + 768 + h * 64 + db * 16 + fq * 4) = pack4(o[db] * inv);
}

__device__ __forceinline__ void mixB_prompt(KP p, int item) {
    const int tid = ltid(), ch = tid & 255, half = tid >> 8, g = ch >> 6, w = 2 << g;
    const int b = item >> 4, c = item & 15, pos0 = c * 128 + half * 64; const size_t tb = (size_t)b * 2048;
    const float* BP = (const float*)(p->ws + WS_BP); bf16_t* ABC = (bf16_t*)(p->ws + WS_R1); float* outP = p->out + O_POOLP;
    float S = 0.f;
    for (int i = 1; i <= w; ++i) { const int ps = pos0 - i; if (ps >= 0) S += BP[(tb + ps) * 256 + ch]; }
    for (int r = 0; r < 64; ++r) { const int pos = pos0 + r; const float xv = BP[(tb + pos) * 256 + ch];
        S += xv; if (pos - w >= 0) S -= BP[(tb + pos - w) * 256 + ch];
        const int cnt = (pos + 1 < w) ? pos + 1 : w;
        ABC[(tb + pos) * 1024 + 512 + ch] = f2bf(S / (float)cnt - xv);
        if (pos >= 2033) outP[(size_t)(b * 15 + pos - 2033) * 256 + ch] = xv; }
}

__device__ __forceinline__ void mix_sample(KP p, int b, LAS unsigned char* lds) {
    const int tid = ltid(), lane = tid & 63, wid = tid >> 6;
    const bf16_t* UV = (const bf16_t*)(p->ws + WS_R2); bf16_t* ABC = (bf16_t*)(p->ws + WS_R1); const float* BP = (const float*)(p->ws + WS_BP); const bf16_t* Q = (const bf16_t*)(p->ws + WS_Q);
    LAS float* red = (LAS float*)lds;
    LAS float* qs = (LAS float*)(lds + 1024);
    LAS float* ps = (LAS float*)(lds + 8192);
    const size_t tokS = (size_t)NPROMPT + b * 4;
    { const int ch = tid; float v0 = bf2f(UV[(tokS + 0) * 1024 + 512 + ch]), v1 = bf2f(UV[(tokS + 1) * 1024 + 512 + ch]), v2 = bf2f(UV[(tokS + 2) * 1024 + 512 + ch]), v3 = bf2f(UV[(tokS + 3) * 1024 + 512 + ch]);
      float r0 = wave_sum(v0), r1 = wave_sum(v1), r2 = wave_sum(v2), r3 = wave_sum(v3), r4 = wave_sum(v0 * v0), r5 = wave_sum(v1 * v1), r6 = wave_sum(v2 * v2), r7 = wave_sum(v3 * v3);
      if (lane == 0) { red[wid * 8 + 0] = r0; red[wid * 8 + 1] = r1; red[wid * 8 + 2] = r2; red[wid * 8 + 3] = r3; red[wid * 8 + 4] = r4; red[wid * 8 + 5] = r5; red[wid * 8 + 6] = r6; red[wid * 8 + 7] = r7; }
      for (int i = tid; i < 1024; i += 512) qs[i] = bf2f(Q[(tokS + (i >> 8)) * 256 + (i & 255)]);
      __syncthreads();
      float sm[8];
#pragma unroll
      for (int k = 0; k < 8; ++k) { float a = 0.f;
#pragma unroll
          for (int w8 = 0; w8 < 8; ++w8) a += red[w8 * 8 + k]; sm[k] = a; }
      const float lg = p->in[13][ch], lb = p->in[14][ch];
      float vn[4]; const float vv[4] = {v0, v1, v2, v3};
#pragma unroll
      for (int t = 0; t < 4; ++t) { const float mean = sm[t] * (1.0f / 512.0f), var = fmaxf(sm[4 + t] * (1.0f / 512.0f) - mean * mean, 0.f);
          vn[t] = (vv[t] - mean) * rsqrtf(var + EPSV) * lg + lb; p->out[O_VS + (size_t)(b * 4 + t) * 512 + ch] = vn[t]; }
      const int g = ch >> 7; const float* wsp = p->in[15] + (size_t)g * 16384; const float* bsp = p->in[16] + g * 128;
#pragma unroll
      for (int t = 0; t < 4; ++t) { float sg = bsp[t];
#pragma unroll
          for (int s = 0; s <= t; ++s) sg += wsp[t * 128 + s] * vn[s];
          const float uu = bf2f(UV[(tokS + t) * 1024 + ch]); ABC[(tokS + t) * 1024 + ch] = f2bf(uu * sg); } }
    if (tid < 256) { const int ch = tid, g = ch >> 6, w = 2 << g; const float* sp = p->in[5] + (size_t)b * 15 * 256; float* outS = p->out + O_POOLS + (size_t)b * 15 * 256;
        for (int t = 0; t < 4; ++t) { float S = 0.f;
            for (int i = 0; i < w; ++i) { const int e = 15 + t - i; S += (e < 15) ? sp[e * 256 + ch] : BP[(tokS + e - 15) * 256 + ch]; }
            const float xv = BP[(tokS + t) * 256 + ch]; ABC[(tokS + t) * 1024 + 512 + ch] = f2bf(S / (float)w - xv); }
        for (int j = 0; j < 15; ++j) outS[j * 256 + ch] = (j < 11) ? sp[(4 + j) * 256 + ch] : BP[(tokS + j - 11) * 256 + ch]; }
    { const int h = wid >> 1, t0 = 2 * (wid & 1); const float* ck = p->in[3] + (size_t)b * 256 * 256 + h * 64; const float* cv = p->in[4] + (size_t)b * 256 * 256 + h * 64;
      float s0[4], s1[4];
#pragma unroll
      for (int i = 0; i < 4; ++i) { const float* kr = ck + (size_t)(lane + 64 * i) * 256; float a0 = 0.f, a1 = 0.f;
#pragma unroll 4
          for (int d4 = 0; d4 < 16; ++d4) { const f32x4 kv = *(const f32x4*)(kr + d4 * 4);
              const f32x4 qa = *(const LAS f32x4*)(qs + t0 * 256 + h * 64 + d4 * 4), qb = *(const LAS f32x4*)(qs + (t0 + 1) * 256 + h * 64 + d4 * 4);
              a0 += kv[0] * qa[0] + kv[1] * qa[1] + kv[2] * qa[2] + kv[3] * qa[3]; a1 += kv[0] * qb[0] + kv[1] * qb[1] + kv[2] * qb[2] + kv[3] * qb[3]; }
          s0[i] = a0; s1[i] = a1; }
      const float m0 = wave_max(fmaxf(fmaxf(s0[0], s0[1]), fmaxf(s0[2], s0[3]))), m1 = wave_max(fmaxf(fmaxf(s1[0], s1[1]), fmaxf(s1[2], s1[3])));
      float e0 = 0.f, e1 = 0.f;
#pragma unroll
      for (int i = 0; i < 4; ++i) { s0[i] = __builtin_amdgcn_exp2f((s0[i] - m0) * 1.442695041f); s1[i] = __builtin_amdgcn_exp2f((s1[i] - m1) * 1.442695041f); e0 += s0[i]; e1 += s1[i]; }
      e0 = 1.0f / wave_sum(e0); e1 = 1.0f / wave_sum(e1);
#pragma unroll
      for (int i = 0; i < 4; ++i) { ps[(wid * 2 + 0) * 256 + lane + 64 * i] = s0[i] * e0; ps[(wid * 2 + 1) * 256 + lane + 64 * i] = s1[i] * e1; }
      __syncthreads();
      float o0 = 0.f, o1 = 0.f;
#pragma unroll 2
      for (int m4 = 0; m4 < 64; ++m4) { const f32x4 pa = *(const LAS f32x4*)(ps + (wid * 2 + 0) * 256 + m4 * 4), pb = *(const LAS f32x4*)(ps + (wid * 2 + 1) * 256 + m4 * 4);
#pragma unroll
          for (int j = 0; j < 4; ++j) { const float vv = cv[(size_t)(m4 * 4 + j) * 256 + lane]; o0 += pa[j] * vv; o1 += pb[j] * vv; } }
      ABC[(tokS + t0) * 1024 + 768 + h * 64 + lane] = f2bf(o0); ABC[(tokS + t0 + 1) * 1024 + 768 + h * 64 + lane] = f2bf(o1); }
    __syncthreads();
}

#ifndef PH
#define PH 0x3ff
#endif
__device__ __forceinline__ void gsync(unsigned* bar, unsigned target) {
    asm volatile("s_waitcnt vmcnt(0) lgkmcnt(0)" ::: "memory");
    __syncthreads();
    if (threadIdx.x == 0) {
        __builtin_amdgcn_fence(__ATOMIC_RELEASE, "agent");
        asm volatile("s_waitcnt vmcnt(0)" ::: "memory");
        __hip_atomic_fetch_add(bar, 1u, __ATOMIC_RELAXED, __HIP_MEMORY_SCOPE_AGENT);
        unsigned spins = 0;
        while (__hip_atomic_load(bar, __ATOMIC_RELAXED, __HIP_MEMORY_SCOPE_AGENT) < target) { __builtin_amdgcn_s_sleep(2); if (++spins > (1u << 24)) break; }
    }
    __syncthreads();
    __builtin_amdgcn_fence(__ATOMIC_ACQUIRE, "agent");
    asm volatile("s_waitcnt vmcnt(0)" ::: "memory");
}
__global__ void __launch_bounds__(512) mega_fwd(Params p_unused) {
    extern __shared__ __attribute__((aligned(16))) unsigned char lds_raw[];
    LAS unsigned char* lds = (LAS unsigned char*)lds_raw;
    const int G = gridDim.x, bx = blockIdx.x;
    unsigned* bar = (unsigned*)(get_params()->ws + WS_BAR);
    cg::this_grid().sync();

#if PH & 1
    { KP p = get_params(); unsigned char* ws = p->ws;
    phase_prep(p, lds);
    }
#endif
    gsync(bar, 1u * (unsigned)G);

#if PH & 2
    { KP p = get_params(); unsigned char* ws = p->ws;
    { Gemm g{(const bf16_t*)(ws + WS_R1), (const bf16_t*)(ws + WS_WIN), MT, DIN, 1024}; StaticOrder S; S.init(MT, DIN, G, bx);
      EpiG1 E{(bf16_t*)(ws + WS_R2), (float*)(ws + WS_BP), (bf16_t*)(ws + WS_Q), (bf16_t*)(ws + WS_R3), p->in[12]};
      gemm_phase(lds, g, S, E);
      Gemm g2{(const bf16_t*)(ws + WS_MEMN), (const bf16_t*)(ws + WS_WKV), 2048, 512, 1024}; StaticOrder S2; S2.init(2048, 512, G, G - 1 - bx);
      EpiKV E2{p->out + O_MK, p->out + O_MV, (bf16_t*)(ws + WS_KB), (bf16_t*)(ws + WS_VT)};
      gemm_phase(lds, g2, S2, E2); }
    }
#endif
    gsync(bar, 2u * (unsigned)G);

#if PH & 4
    { KP p = get_params(); unsigned char* ws = p->ws;
    for (int it = bx; it < 512; it += G) mixA_prompt(p, it, lds);
    for (int it = bx; it < 512; it += G) mixC_prompt(p, it);
    for (int it = bx; it < 128; it += G) mixB_prompt(p, it);
    for (int it = G - 1 - bx; it < 128; it += G) mix_sample(p, it, lds);
    }
#endif
    gsync(bar, 3u * (unsigned)G);

#if PH & 8
    { KP p = get_params(); unsigned char* ws = p->ws;
    { Gemm g{(const bf16_t*)(ws + WS_R1), (const bf16_t*)(ws + WS_WBR), MT, 1024, 1024}; StaticOrder S; S.init(MT, 1024, G, bx);
      EpiG2 E{(const bf16_t*)(ws + WS_R3), (bf16_t*)(ws + WS_R2)};
      gemm_phase(lds, g, S, E); }
    }
#endif
    gsync(bar, 4u * (unsigned)G);

#if PH & 16
    { KP p = get_params(); unsigned char* ws = p->ws;
    { Gemm g{(const bf16_t*)(ws + WS_R2), (const bf16_t*)(ws + WS_WOUT), MT, 1024, 1024}; StaticOrder S; S.init(MT, 1024, G, bx);
      EpiSS E{(float*)(ws + WS_R3), (float*)(ws + WS_SS1)};
      gemm_phase(lds, g, S, E); }
    }
#endif
    gsync(bar, 5u * (unsigned)G);

#if PH & 32
    { KP p = get_params(); unsigned char* ws = p->ws;
    { const int tid = ltid(), lane = tid & 63, wid = tid >> 6; const float* MIX = (const float*)(ws + WS_R3); const float* SS1 = (const float*)(ws + WS_SS1); bf16_t* HN = (bf16_t*)(ws + WS_R1);
      for (int row = bx * 8 + wid; row < MT; row += G * 8) {
          const float* xr = row < NPROMPT ? p->in[0] + (size_t)row * 1024 : p->in[1] + (size_t)(row - NPROMPT) * 1024;
          const f32x4 s0 = *(const f32x4*)(SS1 + (size_t)row * 16), s1 = *(const f32x4*)(SS1 + (size_t)row * 16 + 4), s2 = *(const f32x4*)(SS1 + (size_t)row * 16 + 8), s3 = *(const f32x4*)(SS1 + (size_t)row * 16 + 12);
          const float ss = ((s0[0] + s0[1]) + (s0[2] + s0[3])) + ((s1[0] + s1[1]) + (s1[2] + s1[3])) + ((s2[0] + s2[1]) + (s2[2] + s2[3])) + ((s3[0] + s3[1]) + (s3[2] + s3[3]));
          const float inv = rsqrtf(ss * (1.0f / 1024.0f) + EPSV);
          f32x4 hv[4]; float hs = 0.f;
#pragma unroll
          for (int i = 0; i < 4; ++i) { const int c = lane * 8 + 512 * (i >> 1) + 4 * (i & 1);
              const f32x4 mv = *(const f32x4*)(MIX + (size_t)row * 1024 + c), xv = *(const f32x4*)(xr + c), gp = *(const f32x4*)(p->in[8] + c);
              hv[i] = xv + mv * inv * gp; *(f32x4*)(p->out + O_Y + (size_t)row * 1024 + c) = hv[i];
              hs += (hv[i][0] * hv[i][0] + hv[i][1] * hv[i][1]) + (hv[i][2] * hv[i][2] + hv[i][3] * hv[i][3]); }
          hs = wave_sum(hs); const float inv2 = rsqrtf(hs * (1.0f / 1024.0f) + EPSV);
#pragma unroll
          for (int i = 0; i < 2; ++i) { const int c = lane * 8 + 512 * i; const f32x4 g0 = *(const f32x4*)(p->in[9] + c), g1 = *(const f32x4*)(p->in[9] + c + 4);
              *(u32x4*)(HN + (size_t)row * 1024 + c) = pack8(hv[2 * i] * inv2 * g0, hv[2 * i + 1] * inv2 * g1); } } }
    }
#endif
    gsync(bar, 6u * (unsigned)G);

#if PH & 64
    { KP p = get_params(); unsigned char* ws = p->ws;
    { Gemm g{(const bf16_t*)(ws + WS_R1), (const bf16_t*)(ws + WS_WUP), MT, NUP, 1024}; StaticOrder S; S.init(MT, NUP, G, bx);
      EpiG4 E{(bf16_t*)(ws + WS_R3), (float*)(ws + WS_GRAW), (float*)(ws + WS_URAW), p->in[26], p->in[27], p->in[6], p->out + O_CONVP, p->out + O_CONVS};
      gemm_phase(lds, g, S, E); }
    }
#endif
    gsync(bar, 7u * (unsigned)G);

#if PH & 128
    { KP p = get_params(); unsigned char* ws = p->ws;
    { const int tid = ltid(); const float* GRAW = (const float*)(ws + WS_GRAW); const float* URAW = (const float*)(ws + WS_URAW); bf16_t* Y = (bf16_t*)(ws + WS_R3);
      const float* cw = p->in[26]; const float* cb = p->in[27];
      for (int idx = bx * 512 + tid; idx < 128 * 2 * DFF; idx += G * 512) {
          const int seg = idx / (2 * DFF), rem = idx - seg * 2 * DFF, j = rem / DFF, ch = rem - j * DFF; const bool first = (seg & 15) == 0;
          float gm2, gm1, g0;
          if (j == 0) { gm2 = first ? 0.f : GRAW[(size_t)((seg - 1) * 4 + 0) * DFF + ch]; gm1 = first ? 0.f : GRAW[(size_t)((seg - 1) * 4 + 1) * DFF + ch]; g0 = GRAW[(size_t)(seg * 4 + 2) * DFF + ch]; }
          else { gm2 = first ? 0.f : GRAW[(size_t)((seg - 1) * 4 + 1) * DFF + ch]; gm1 = GRAW[(size_t)(seg * 4 + 2) * DFF + ch]; g0 = GRAW[(size_t)(seg * 4 + 3) * DFF + ch]; }
          const float c = cb[ch] + cw[ch] * gm2 + cw[DFF + ch] * gm1 + cw[2 * DFF + ch] * g0;
          Y[((size_t)seg * 128 + j) * DFF + ch] = f2bf(gelu1(c) * URAW[(size_t)(seg * 2 + j) * DFF + ch]); } }
    }
#endif
    gsync(bar, 8u * (unsigned)G);

#if PH & 256
    { KP p = get_params(); unsigned char* ws = p->ws;
    { Gemm g{(const bf16_t*)(ws + WS_R3), (const bf16_t*)(ws + WS_WDOWN), MT, 1024, DFF}; StaticOrder S; S.init(MT, 1024, G, bx);
      EpiSS E{(float*)(ws + WS_R1), (float*)(ws + WS_SS2)};
      gemm_phase(lds, g, S, E); }
    }
#endif
    gsync(bar, 9u * (unsigned)G);

#if PH & 512
    { KP p = get_params(); unsigned char* ws = p->ws;
    { const int tid = ltid(), lane = tid & 63, wid = tid >> 6; const float* F = (const float*)(ws + WS_R1); const float* SS2 = (const float*)(ws + WS_SS2);
      for (int row = bx * 8 + wid; row < MT; row += G * 8) {
          const f32x4 s0 = *(const f32x4*)(SS2 + (size_t)row * 16), s1 = *(const f32x4*)(SS2 + (size_t)row * 16 + 4), s2 = *(const f32x4*)(SS2 + (size_t)row * 16 + 8), s3 = *(const f32x4*)(SS2 + (size_t)row * 16 + 12);
          const float ss = ((s0[0] + s0[1]) + (s0[2] + s0[3])) + ((s1[0] + s1[1]) + (s1[2] + s1[3])) + ((s2[0] + s2[1]) + (s2[2] + s2[3])) + ((s3[0] + s3[1]) + (s3[2] + s3[3]));
          const float inv = rsqrtf(ss * (1.0f / 1024.0f) + EPSV);
#pragma unroll
          for (int i = 0; i < 4; ++i) { const int c = lane * 4 + 256 * i; float* op = p->out + O_Y + (size_t)row * 1024 + c;
              const f32x4 fv = *(const f32x4*)(F + (size_t)row * 1024 + c), hv = *(const f32x4*)op, gp = *(const f32x4*)(p->in[10] + c);
              *(f32x4*)op = hv + fv * inv * gp; } } }
    }
#endif
#ifdef DUMP_OFF
    gsync(bar, 10u * (unsigned)G);
    { KP p = get_params(); const int tid = ltid();
      if (DUMP_F32) { const float* src = (const float*)(p->ws + DUMP_OFF); for (size_t i = (size_t)bx * 512 + tid; i < (size_t)MT * 1024; i += (size_t)G * 512) p->out[i] = src[i]; }
      else { const bf16_t* src = (const bf16_t*)(p->ws + DUMP_OFF); for (size_t i = (size_t)bx * 512 + tid; i < (size_t)MT * 1024; i += (size_t)G * 512) p->out[i] = bf2f(src[i]); } }
#endif
}

extern "C" void kernel_launch(void* const* d_in, const int* in_sizes, int n_in, void* d_out, int out_size, void* d_ws, size_t ws_size, hipStream_t stream) {
    static int grid = 0;
    if (grid == 0) {
        if (n_in != 29 || ws_size < WS_END) { fprintf(stderr, "kernel_launch: unexpected n_in %d / ws_size %zu (need %zu)\n", n_in, ws_size, (size_t)WS_END); grid = -1; return; }
        int dev = 0, cus = 0, per_cu = 0;
        (void)hipGetDevice(&dev); (void)hipDeviceGetAttribute(&cus, hipDeviceAttributeMultiprocessorCount, dev);
        if (hipFuncSetAttribute((const void*)mega_fwd, hipFuncAttributeMaxDynamicSharedMemorySize, LDS_BYTES) != hipSuccess) fprintf(stderr, "kernel_launch: hipFuncSetAttribute failed\n");
        if (hipOccupancyMaxActiveBlocksPerMultiprocessor(&per_cu, (const void*)mega_fwd, 512, LDS_BYTES) != hipSuccess || per_cu < 1) per_cu = 1;
        (void)hipGetLastError();
        grid = cus * per_cu; if (grid <= 0) grid = 256;
    }
    if (grid < 0) return;
    Params p{};
    for (int i = 0; i < 29; ++i) p.in[i] = (const float*)d_in[i];
    p.out = (float*)d_out; p.ws = (unsigned char*)d_ws;
    (void)hipMemsetAsync((unsigned char*)d_ws + WS_BAR, 0, 256, stream);
    void* args[] = {&p};
    hipError_t e = hipLaunchCooperativeKernel((const void*)mega_fwd, dim3(grid), dim3(512), args, LDS_BYTES, stream);
    if (e != hipSuccess) fprintf(stderr, "cooperative launch failed: %s (grid %d)\n", hipGetErrorString(e), grid);
}
```

```cpp
#include <hip/hip_runtime.h>
#include <hip/hip_cooperative_groups.h>
#include <cstdio>
namespace cg = cooperative_groups;

#define LAS __attribute__((address_space(3)))
typedef unsigned short bf16_t;
typedef short bf16x8 __attribute__((ext_vector_type(8)));
typedef float f32x4 __attribute__((ext_vector_type(4)));
typedef float f32x2 __attribute__((ext_vector_type(2)));
typedef unsigned u32x4 __attribute__((ext_vector_type(4)));
typedef unsigned u32x2 __attribute__((ext_vector_type(2)));

constexpr int DM = 1024, NPROMPT = 16384, NSAMP = 512, MT = NPROMPT + NSAMP;
constexpr int DIN = 4608, DFF = 2816, NUP = 2 * DFF;
constexpr float EPSV = 1e-6f;
constexpr int LDS_BYTES = 131072 + 8192;

constexpr size_t O_Y = 0, O_MK = 17301504, O_MV = 17825792, O_POOLP = 18350080, O_CONVP = 18380800, O_VS = 18425856, O_POOLS = 18688000, O_CONVS = 19179520;
constexpr size_t WS_WIN = 0, WS_WKV = WS_WIN + 9437184, WS_WBR = WS_WKV + 1048576, WS_WOUT = WS_WBR + 2097152, WS_WUP = WS_WOUT + 2097152,
                 WS_WDOWN = WS_WUP + 11534336, WS_WST = WS_WDOWN + 5767168, WS_R1 = WS_WST + 131072, WS_R2 = WS_R1 + 34603008, WS_R3 = WS_R2 + 34603008,
                 WS_BP = WS_R3 + 103809024, WS_Q = WS_BP + 17301504, WS_MEMN = WS_Q + 8650752, WS_KB = WS_MEMN + 4194304, WS_VT = WS_KB + 1048576,
                 WS_SS1 = WS_VT + 1048576, WS_SS2 = WS_SS1 + 1081344, WS_GRAW = WS_SS2 + 1081344, WS_URAW = WS_GRAW + 5767168, WS_BAR = WS_URAW + 2883584, WS_END = WS_BAR + 16384;

struct Params {
    const float* in[29];
    float* out;
    unsigned char* ws;
};

typedef const __attribute__((address_space(4))) Params* KP;
__device__ __forceinline__ KP get_params() { unsigned long long kp = (unsigned long long)__builtin_amdgcn_kernarg_segment_ptr(); asm volatile("" : "+s"(kp)); return (KP)kp; }
__device__ __forceinline__ int ltid() { int t = threadIdx.x; asm volatile("" : "+v"(t)); return t; }
typedef __bf16 bf16x2_t __attribute__((ext_vector_type(2)));
__device__ __forceinline__ unsigned cvt_pk_bf16(float lo, float hi) { f32x2 v = {lo, hi}; bf16x2_t r = __builtin_convertvector(v, bf16x2_t); return __builtin_bit_cast(unsigned, r); }
__device__ __forceinline__ bf16_t f2bf(float x) { return (bf16_t)(cvt_pk_bf16(x, x) & 0xffffu); }
__device__ __forceinline__ float bf2f(bf16_t b) { return __uint_as_float(((unsigned)b) << 16); }
__device__ __forceinline__ float bflo(unsigned w) { return __uint_as_float(w << 16); }
__device__ __forceinline__ float bfhi(unsigned w) { return __uint_as_float(w & 0xffff0000u); }
__device__ __forceinline__ void unpack8(const u32x4 w, f32x4& a, f32x4& b) {
    a[0] = bflo(w[0]); a[1] = bfhi(w[0]); a[2] = bflo(w[1]); a[3] = bfhi(w[1]);
    b[0] = bflo(w[2]); b[1] = bfhi(w[2]); b[2] = bflo(w[3]); b[3] = bfhi(w[3]);
}
__device__ __forceinline__ f32x4 unpack4(const u32x2 w) { f32x4 a; a[0] = bflo(w[0]); a[1] = bfhi(w[0]); a[2] = bflo(w[1]); a[3] = bfhi(w[1]); return a; }
__device__ __forceinline__ u32x2 pack4(const f32x4 v) { u32x2 w; w[0] = cvt_pk_bf16(v[0], v[1]); w[1] = cvt_pk_bf16(v[2], v[3]); return w; }
__device__ __forceinline__ u32x4 pack8(const f32x4 a, const f32x4 b) { u32x4 w; w[0] = cvt_pk_bf16(a[0], a[1]); w[1] = cvt_pk_bf16(a[2], a[3]); w[2] = cvt_pk_bf16(b[0], b[1]); w[3] = cvt_pk_bf16(b[2], b[3]); return w; }
__device__ __forceinline__ float gelu1(float x) {
    const float u = x * (0.7978845608f + 0.0356774081f * x * x);
    const float e = __builtin_amdgcn_exp2f(-2.885390082f * u);
    return x * __builtin_amdgcn_rcpf(1.0f + e);
}
__device__ __forceinline__ f32x4 gelu4(f32x4 v) { f32x4 o; o[0] = gelu1(v[0]); o[1] = gelu1(v[1]); o[2] = gelu1(v[2]); o[3] = gelu1(v[3]); return o; }
__device__ __forceinline__ float sigm1(float x) { x = fminf(fmaxf(x, -30.f), 30.f); return __builtin_amdgcn_rcpf(1.0f + __builtin_amdgcn_exp2f(-1.442695041f * x)); }
__device__ __forceinline__ float wave_sum(float v) {
    v += __shfl_xor(v, 1); v += __shfl_xor(v, 2); v += __shfl_xor(v, 4); v += __shfl_xor(v, 8); v += __shfl_xor(v, 16); v += __shfl_xor(v, 32); return v;
}
__device__ __forceinline__ float wave_max(float v) {
    v = fmaxf(v, __shfl_xor(v, 1)); v = fmaxf(v, __shfl_xor(v, 2)); v = fmaxf(v, __shfl_xor(v, 4)); v = fmaxf(v, __shfl_xor(v, 8)); v = fmaxf(v, __shfl_xor(v, 16)); v = fmaxf(v, __shfl_xor(v, 32)); return v;
}
__device__ __forceinline__ float dpp_shr1(float v) { return __int_as_float(__builtin_amdgcn_update_dpp(0, __float_as_int(v), 0x111, 0xf, 0xf, true)); }
__device__ __forceinline__ f32x4 dpp_shr1_4(f32x4 v) { f32x4 o; o[0] = dpp_shr1(v[0]); o[1] = dpp_shr1(v[1]); o[2] = dpp_shr1(v[2]); o[3] = dpp_shr1(v[3]); return o; }

constexpr int BM = 256, BK = 64, HALF = 128, HTB = HALF * BK * 2, NXCD = 8, WGM = 8;
__device__ __forceinline__ int lds_byte(int r, int c) { const int st = (r >> 4) * 2 + (c >> 5), rr = r & 15, cc = c & 31, ob = rr * 64 + cc * 2; return st * 1024 + (ob ^ (((ob >> 9) & 1) << 5)); }
__device__ __forceinline__ void stage_rc(int b, int& R, int& C) { const int st = b / 1024, sb = b % 1024, swz = sb ^ (((sb >> 9) & 1) << 5); R = (st >> 1) * 16 + swz / 64; C = (st & 1) * 32 + (swz % 64) / 2; }
__device__ __forceinline__ int perm32(int rho) { const int n = rho >> 4, i = rho & 15; return 8 * (i >> 2) + 4 * n + (i & 3); }

struct Unit { int pm, pn; };
struct Gemm { const bf16_t* A; const bf16_t* Bt; int M, N, K; };
struct StaticOrder {
    int nM, nN, nwg, G, c;
    __device__ void init(int M, int N, int G_, int c_) { nM = M / BM; nN = N / BM; nwg = nM * nN; G = G_; c = c_; }
    __device__ bool next(int i, Unit& u) const {
        const long L = (long)i * G + c; if (L >= nwg || c < 0) return false;
        int wgid = (int)L; { const int q = nwg / NXCD, r = nwg % NXCD, xcd = wgid % NXCD, off = wgid / NXCD; wgid = (xcd < r ? xcd * (q + 1) : r * (q + 1) + (xcd - r) * q) + off; }
        const int nig = WGM * nN, gid = wgid / nig, fm = gid * WGM, gsz = (nM - fm) < WGM ? (nM - fm) : WGM;
        u.pm = fm + ((wgid % nig) % gsz); u.pn = (wgid % nig) / gsz; return true;
    }
};

struct OneUnit { Unit u; __device__ bool next(int i, Unit& o) const { if (i != 0) return false; o = u; return true; } };
template <class Epi, class Sched>
__device__ __forceinline__ void gemm_phase(LAS unsigned char* lds, const Gemm g, const Sched& S, const Epi& E) {
    const int tid = ltid(), wid = __builtin_amdgcn_readfirstlane(tid >> 6), lane = tid & 63, wr = wid >> 2, wc = wid & 3, fr = lane & 15, fq = lane >> 4;
    const int K = g.K, nt = K / BK;
    unsigned voffA[2], voffB[2];
#pragma unroll
    for (int i = 0; i < 2; ++i) { int R, C; stage_rc(tid * 16 + i * 8192, R, C); const int Rb = Epi::PERM ? ((R & ~31) + perm32(R & 31)) : R;
        const int Ra = Epi::PERMA ? (128 * (R >> 6) + 8 * (R & 15) + ((R >> 4) & 3)) : R;
        voffA[i] = (unsigned)(Ra * K + C) * 2u; voffB[i] = (unsigned)(Rb * K + C) * 2u; }
    const size_t kstep = (size_t)(BK * 2);
    const size_t hstep = (size_t)HALF * K * 2;
    const size_t hstepA = Epi::PERMA ? (size_t)4 * K * 2 : hstep;
    const size_t tstep = 2 * hstep;
    const unsigned ldsw = (unsigned)wid * 1024u;
    const int aoff = lds_byte(wr * 64 + fr, fq * 8), boff = lds_byte(wc * 32 + fr, fq * 8);
#define PG8_SA(b, h) (((b) * 2 + (h)) * HTB)
#define PG8_SB(b, h) ((4 + (b) * 2 + (h)) * HTB)
#define PG8_STAGE(bufoff, gbase, voff) do { _Pragma("unroll") for (int _i = 0; _i < 2; ++_i) \
        __builtin_amdgcn_global_load_lds((const unsigned*)((const char*)(gbase) + (voff)[_i]), (LAS unsigned*)(lds + (bufoff) + ldsw + _i * 8192), 16, 0, 0); } while (0)
#define PG8_LDA(dst, b, h) do { _Pragma("unroll") for (int m = 0; m < 4; ++m) _Pragma("unroll") for (int k = 0; k < 2; ++k) dst[m][k] = *(const LAS bf16x8*)(lds + PG8_SA(b, h) + aoff + m * 2048 + k * 1024); } while (0)
#define PG8_LDB(dst, b, h) do { _Pragma("unroll") for (int n = 0; n < 2; ++n) _Pragma("unroll") for (int k = 0; k < 2; ++k) dst[n][k] = *(const LAS bf16x8*)(lds + PG8_SB(b, h) + boff + n * 2048 + k * 1024); } while (0)
#define PG8_MMA(ai, bj, At, Bt) do { __builtin_amdgcn_s_setprio(1); _Pragma("unroll") for (int m = 0; m < 4; ++m) _Pragma("unroll") for (int n = 0; n < 2; ++n) _Pragma("unroll") for (int k = 0; k < 2; ++k) \
        acc[ai][bj][m][n] = __builtin_amdgcn_mfma_f32_16x16x32_bf16(Bt[n][k], At[m][k], acc[ai][bj][m][n], 0, 0, 0); __builtin_amdgcn_s_setprio(0); } while (0)
#define PG8_WAIT_V(n) asm volatile("s_waitcnt vmcnt(" #n ")" ::: "memory")
#define PG8_WAIT_L(n) asm volatile("s_waitcnt lgkmcnt(" #n ")" ::: "memory")
#define PG8_BAR __builtin_amdgcn_s_barrier()
#define PG8_SCHED __builtin_amdgcn_sched_barrier(0)
    Unit cur, nxt; int ui = 0;
    if (!S.next(0, cur)) return;
    E.pin();
    asm volatile("s_waitcnt lgkmcnt(0)" ::: "memory");
    f32x4 acc[2][2][4][2];
#pragma unroll
    for (int a = 0; a < 2; ++a)
#pragma unroll
        for (int b = 0; b < 2; ++b)
#pragma unroll
            for (int m = 0; m < 4; ++m)
#pragma unroll
                for (int n = 0; n < 2; ++n) acc[a][b][m][n] = (f32x4){0.f, 0.f, 0.f, 0.f};
    bf16x8 At[4][2], B0[2][2], B1[2][2];
    const char* cA = (const char*)g.A + (size_t)cur.pm * tstep; const char* cB = (const char*)g.Bt + (size_t)cur.pn * tstep;
    PG8_STAGE(PG8_SB(0, 0), cB, voffB); PG8_STAGE(PG8_SA(0, 0), cA, voffA); PG8_STAGE(PG8_SB(0, 1), cB + hstep, voffB); PG8_STAGE(PG8_SA(0, 1), cA + hstepA, voffA);
    if (wr == 1) PG8_BAR;
    PG8_WAIT_V(4); PG8_BAR;
    PG8_STAGE(PG8_SB(1, 0), cB + kstep, voffB); PG8_STAGE(PG8_SA(1, 0), cA + kstep, voffA); PG8_STAGE(PG8_SB(1, 1), cB + hstep + kstep, voffB);
    PG8_WAIT_V(6); PG8_BAR;
    for (;;) {
        const bool has_next = S.next(ui + 1, nxt);
        const char* nA = has_next ? (const char*)g.A + (size_t)nxt.pm * tstep : cA; const char* nB = has_next ? (const char*)g.Bt + (size_t)nxt.pn * tstep : cB;
        for (int t = 0; t < nt; t += 2) {
            const bool last = (t == nt - 2);
            const char* a1 = cA + (size_t)(t + 1) * kstep;
            const char* a2 = last ? nA : cA + (size_t)(t + 2) * kstep; const char* b2 = last ? nB : cB + (size_t)(t + 2) * kstep;
            const char* a3 = a2 + kstep; const char* b3 = b2 + kstep;
            if constexpr (Epi::MID) { if (t == 8 || t == 12) E.mid(acc, cur, t, wr, wc, fr, fq); }
            PG8_LDB(B0, 0, 0); PG8_SCHED; PG8_LDA(At, 0, 0); PG8_STAGE(PG8_SA(1, 1), a1 + hstepA, voffA);
            PG8_WAIT_L(8); PG8_BAR; PG8_WAIT_L(0); PG8_MMA(0, 0, At, B0); PG8_BAR; PG8_SCHED;
            PG8_LDB(B1, 0, 1); PG8_STAGE(PG8_SB(0, 0), b2, voffB);
            PG8_BAR; PG8_WAIT_L(0); PG8_MMA(0, 1, At, B1); PG8_BAR;
            PG8_LDA(At, 0, 1); PG8_STAGE(PG8_SA(0, 0), a2, voffA);
            PG8_BAR; PG8_WAIT_L(0); PG8_MMA(1, 0, At, B0); PG8_BAR; PG8_SCHED;
            PG8_STAGE(PG8_SB(0, 1), b2 + hstep, voffB);
            PG8_WAIT_V(6); PG8_BAR; PG8_MMA(1, 1, At, B1); PG8_BAR;
            PG8_LDB(B0, 1, 0); PG8_SCHED; PG8_LDA(At, 1, 0); PG8_STAGE(PG8_SA(0, 1), a2 + hstepA, voffA);
            PG8_WAIT_L(8); PG8_BAR; PG8_WAIT_L(0); PG8_MMA(0, 0, At, B0); PG8_BAR; PG8_SCHED;
            PG8_LDB(B1, 1, 1); PG8_STAGE(PG8_SB(1, 0), b3, voffB);
            PG8_BAR; PG8_WAIT_L(0); PG8_MMA(0, 1, At, B1); PG8_BAR;
            PG8_LDA(At, 1, 1); PG8_STAGE(PG8_SA(1, 0), a3, voffA);
            PG8_BAR; PG8_WAIT_L(0); PG8_MMA(1, 0, At, B0); PG8_BAR; PG8_SCHED;
            PG8_STAGE(PG8_SB(1, 1), b3 + hstep, voffB);
            PG8_WAIT_V(6); PG8_BAR; PG8_MMA(1, 1, At, B1); PG8_BAR;
        }
        if constexpr (!Epi::DRAIN) E(acc, cur, wr, wc, fr, fq);
        if (!has_next) break;
#pragma unroll
        for (int a = 0; a < 2; ++a)
#pragma unroll
            for (int b = 0; b < 2; ++b)
#pragma unroll
                for (int m = 0; m < 4; ++m)
#pragma unroll
                    for (int n = 0; n < 2; ++n) acc[a][b][m][n] = (f32x4){0.f, 0.f, 0.f, 0.f};
        cur = nxt; cA = nA; cB = nB; ++ui;
    }
    PG8_WAIT_V(0);
    if (wr == 0) PG8_BAR;
    PG8_BAR;
    if constexpr (Epi::DRAIN) E(acc, cur, wr, wc, fr, fq);
#undef PG8_SA
#undef PG8_SB
#undef PG8_STAGE
#undef PG8_LDA
#undef PG8_LDB
#undef PG8_MMA
#undef PG8_WAIT_V
#undef PG8_WAIT_L
#undef PG8_BAR
#undef PG8_SCHED
}

typedef f32x4 Acc[2][2][4][2];

struct EpiG1 {
    static constexpr bool PERM = true, PERMA = false, MID = false, DRAIN = false;
    bf16_t* UV; float* BP; bf16_t* Q; bf16_t* GATES; const float* bgate;
    __device__ __forceinline__ void pin() const { asm volatile("" :: "s"(UV), "s"(BP), "s"(Q), "s"(GATES), "s"(bgate)); }
    __device__ __forceinline__ void operator()(const Acc& acc, const Unit& u, int wr, int wc, int fr, int fq) const {
        const int row0 = u.pm * BM + wr * 64 + fr, colw = wc * 32 + 8 * fq;
        if (u.pn < 4) {
#pragma unroll
            for (int ai = 0; ai < 2; ++ai)
#pragma unroll
                for (int m = 0; m < 4; ++m) { bf16_t* rowp = UV + (size_t)(row0 + ai * HALF + m * 16) * 1024 + u.pn * 256 + colw;
#pragma unroll
                    for (int bj = 0; bj < 2; ++bj) *(u32x4*)(rowp + bj * HALF) = pack8(gelu4(acc[ai][bj][m][0]), gelu4(acc[ai][bj][m][1])); }
        } else if (u.pn == 4) {
#pragma unroll
            for (int ai = 0; ai < 2; ++ai)
#pragma unroll
                for (int m = 0; m < 4; ++m) { float* rowp = BP + (size_t)(row0 + ai * HALF + m * 16) * 256 + colw;
#pragma unroll
                    for (int bj = 0; bj < 2; ++bj) { *(f32x4*)(rowp + bj * HALF) = acc[ai][bj][m][0]; *(f32x4*)(rowp + bj * HALF + 4) = acc[ai][bj][m][1]; } }
        } else if (u.pn == 5) {
#pragma unroll
            for (int ai = 0; ai < 2; ++ai)
#pragma unroll
                for (int m = 0; m < 4; ++m) { bf16_t* rowp = Q + (size_t)(row0 + ai * HALF + m * 16) * 256 + colw;
#pragma unroll
                    for (int bj = 0; bj < 2; ++bj) *(u32x4*)(rowp + bj * HALF) = pack8(acc[ai][bj][m][0] * 0.125f, acc[ai][bj][m][1] * 0.125f); }
        } else {
            const int gc0 = (u.pn - 6) * 256 + colw;
            f32x4 bv[2][2];
#pragma unroll
            for (int bj = 0; bj < 2; ++bj)
#pragma unroll
                for (int n = 0; n < 2; ++n) bv[bj][n] = *(const f32x4*)(bgate + gc0 + bj * HALF + 4 * n);
#pragma unroll
            for (int ai = 0; ai < 2; ++ai)
#pragma unroll
                for (int m = 0; m < 4; ++m) { bf16_t* rowp = GATES + (size_t)(row0 + ai * HALF + m * 16) * 3072 + gc0;
#pragma unroll
                    for (int bj = 0; bj < 2; ++bj) { f32x4 v0 = acc[ai][bj][m][0] + bv[bj][0], v1 = acc[ai][bj][m][1] + bv[bj][1];
#pragma unroll
                        for (int j = 0; j < 4; ++j) { v0[j] = sigm1(v0[j]); v1[j] = sigm1(v1[j]); }
                        *(u32x4*)(rowp + bj * HALF) = pack8(v0, v1); } }
        }
    }
};

struct EpiKV {
    static constexpr bool PERM = false, PERMA = false, MID = false, DRAIN = false;
    float* outK; float* outV; bf16_t* KB; bf16_t* VT;
    __device__ __forceinline__ void pin() const { asm volatile("" :: "s"(outK), "s"(outV), "s"(KB), "s"(VT)); }
    __device__ __forceinline__ void operator()(const Acc& acc, const Unit& u, int wr, int wc, int fr, int fq) const {
#pragma unroll
        for (int ai = 0; ai < 2; ++ai)
#pragma unroll
            for (int m = 0; m < 4; ++m) { const int r = u.pm * BM + ai * HALF + wr * 64 + m * 16 + fr;
#pragma unroll
                for (int bj = 0; bj < 2; ++bj)
#pragma unroll
                    for (int n = 0; n < 2; ++n) { const int c = bj * HALF + wc * 32 + n * 16 + 4 * fq; const f32x4 v = acc[ai][bj][m][n];
                        if (u.pn == 0) { *(f32x4*)(outK + (size_t)r * 256 + c) = v; *(u32x2*)(KB + (size_t)r * 256 + c) = pack4(v); }
                        else { *(f32x4*)(outV + (size_t)r * 256 + c) = v; const int b = r >> 8, mm = r & 255, h = c >> 6, d = c & 63;
                            bf16_t* vt = VT + ((size_t)((b * 4 + h) * 64 + d)) * 256 + mm;
                            vt[0] = f2bf(v[0]); vt[256] = f2bf(v[1]); vt[512] = f2bf(v[2]); vt[768] = f2bf(v[3]); } } }
    }
};

struct EpiG2 {
    static constexpr bool PERM = true, PERMA = false, MID = true, DRAIN = false;
    const bf16_t* GATES; bf16_t* MERGED;
    __device__ __forceinline__ void pin() const { asm volatile("" :: "s"(GATES), "s"(MERGED)); }
    __device__ __forceinline__ void mid(Acc& acc, const Unit& u, int t, int wr, int wc, int fr, int fq) const {
        int row0 = u.pm * BM + wr * 64 + fr; asm volatile("" : "+v"(row0));
        const int col0 = u.pn * 256 + wc * 32 + 8 * fq;
        const int nb = (t == 8) ? 0 : 1024;
#pragma unroll
        for (int ai = 0; ai < 2; ++ai)
#pragma unroll
            for (int m = 0; m < 4; ++m) { const bf16_t* gp = GATES + (size_t)(row0 + ai * HALF + m * 16) * 3072 + nb + col0;
#pragma unroll
                for (int bj = 0; bj < 2; ++bj) { const u32x4 wn = *(const u32x4*)(gp + bj * HALF), wd = *(const u32x4*)(gp + 1024 + bj * HALF);
                    f32x4 n0, n1, d0, d1; unpack8(wn, n0, n1); unpack8(wd, d0, d1);
#pragma unroll
                    for (int j = 0; j < 4; ++j) { acc[ai][bj][m][0][j] *= n0[j] * __builtin_amdgcn_rcpf(d0[j]); acc[ai][bj][m][1][j] *= n1[j] * __builtin_amdgcn_rcpf(d1[j]); } }
                asm volatile("" ::: "memory"); }
    }
    __device__ __forceinline__ void operator()(const Acc& acc, const Unit& u, int wr, int wc, int fr, int fq) const {
        const int row0 = u.pm * BM + wr * 64 + fr, col0 = u.pn * 256 + wc * 32 + 8 * fq;
#pragma unroll
        for (int ai = 0; ai < 2; ++ai)
#pragma unroll
            for (int m = 0; m < 4; ++m) { const size_t r = (size_t)(row0 + ai * HALF + m * 16);
#pragma unroll
                for (int bj = 0; bj < 2; ++bj) { const u32x4 wg = *(const u32x4*)(GATES + r * 3072 + 2048 + col0 + bj * HALF); f32x4 g0, g1; unpack8(wg, g0, g1);
                    *(u32x4*)(MERGED + r * 1024 + col0 + bj * HALF) = pack8(acc[ai][bj][m][0] * g0, acc[ai][bj][m][1] * g1); }
                asm volatile("" ::: "memory"); }
    }
};

struct EpiSS {
    static constexpr bool PERM = false, PERMA = false, MID = false, DRAIN = false;
    float* C; float* SS;
    __device__ __forceinline__ void pin() const { asm volatile("" :: "s"(C), "s"(SS)); }
    __device__ __forceinline__ void operator()(const Acc& acc, const Unit& u, int wr, int wc, int fr, int fq) const {
        const int row0 = u.pm * BM + wr * 64 + fr, col0 = u.pn * BM + wc * 32 + 4 * fq;
#pragma unroll
        for (int ai = 0; ai < 2; ++ai)
#pragma unroll
            for (int m = 0; m < 4; ++m) { const size_t r = (size_t)(row0 + ai * HALF + m * 16); float* rowp = C + r * 1024 + col0; float s = 0.f;
#pragma unroll
                for (int bj = 0; bj < 2; ++bj)
#pragma unroll
                    for (int n = 0; n < 2; ++n) { const f32x4 v = acc[ai][bj][m][n]; *(f32x4*)(rowp + bj * HALF + n * 16) = v; s += (v[0] * v[0] + v[1] * v[1]) + (v[2] * v[2] + v[3] * v[3]); }
                s += __shfl_xor(s, 16); s += __shfl_xor(s, 32);
                if (fq == 0) SS[r * 16 + u.pn * 4 + wc] = s; }
    }
};

struct EpiG4 {
    static constexpr bool PERM = true, PERMA = true, MID = false, DRAIN = false;
    bf16_t* Y; float* GRAW; float* URAW; const float* cw; const float* cb; const float* sconv; float* outCP; float* outCS;
    __device__ __forceinline__ void pin() const { asm volatile("" :: "s"(Y), "s"(GRAW), "s"(URAW), "s"(cw), "s"(cb), "s"(sconv), "s"(outCP), "s"(outCS)); }
    __device__ __forceinline__ void operator()(const Acc& acc, const Unit& u, int wr, int wc, int fr, int fq) const {
#pragma unroll
        for (int n = 0; n < 2; ++n) {
            const int ch = u.pn * 128 + wc * 32 + 8 * fq + 4 * n;
            const f32x4 w0 = *(const f32x4*)(cw + ch), w1 = *(const f32x4*)(cw + DFF + ch), w2 = *(const f32x4*)(cw + 2 * DFF + ch), bb = *(const f32x4*)(cb + ch);
            if (u.pm < 64) {
                const int seg = 2 * u.pm + wr; const size_t tok0 = (size_t)seg * 128 + 8 * fr;
                f32x4 p2 = dpp_shr1_4(acc[1][0][2][n]), p1 = dpp_shr1_4(acc[1][0][3][n]);
#pragma unroll
                for (int j8 = 0; j8 < 8; ++j8) { const f32x4 gv = acc[j8 >> 2][0][j8 & 3][n], uv = acc[j8 >> 2][1][j8 & 3][n];
                    const f32x4 c = bb + w0 * p2 + w1 * p1 + w2 * gv;
                    if (!(fr == 0 && j8 < 2)) *(u32x2*)(Y + (tok0 + j8) * DFF + ch) = pack4(gelu4(c) * uv);
                    p2 = p1; p1 = gv; }
                if (fr == 0) {
                    *(f32x4*)(GRAW + (size_t)(seg * 4 + 2) * DFF + ch) = acc[0][0][0][n]; *(f32x4*)(GRAW + (size_t)(seg * 4 + 3) * DFF + ch) = acc[0][0][1][n];
                    *(f32x4*)(URAW + (size_t)(seg * 2 + 0) * DFF + ch) = acc[0][1][0][n]; *(f32x4*)(URAW + (size_t)(seg * 2 + 1) * DFF + ch) = acc[0][1][1][n];
                }
                if (fr == 15) {
                    *(f32x4*)(GRAW + (size_t)(seg * 4 + 0) * DFF + ch) = acc[1][0][2][n]; *(f32x4*)(GRAW + (size_t)(seg * 4 + 1) * DFF + ch) = acc[1][0][3][n];
                    if ((seg & 15) == 15) { const int b = seg >> 4; *(f32x4*)(outCP + (size_t)(b * 2 + 0) * DFF + ch) = acc[1][0][2][n]; *(f32x4*)(outCP + (size_t)(b * 2 + 1) * DFF + ch) = acc[1][0][3][n]; }
                }
            } else {
                const int si0 = 256 * (u.pm - 64) + 128 * wr + 8 * fr;
#pragma unroll
                for (int hh = 0; hh < 2; ++hh) { const int b = (si0 >> 2) + hh;
                    f32x4 p2 = *(const f32x4*)(sconv + (size_t)(b * 2 + 0) * DFF + ch), p1 = *(const f32x4*)(sconv + (size_t)(b * 2 + 1) * DFF + ch);
#pragma unroll
                    for (int t = 0; t < 4; ++t) { const f32x4 gv = acc[hh][0][t][n], uv = acc[hh][1][t][n];
                        const f32x4 c = bb + w0 * p2 + w1 * p1 + w2 * gv;
                        *(u32x2*)(Y + (size_t)(NPROMPT + b * 4 + t) * DFF + ch) = pack4(gelu4(c) * uv);
                        p2 = p1; p1 = gv; }
                    *(f32x4*)(outCS + (size_t)(b * 2 + 0) * DFF + ch) = acc[hh][0][2][n]; *(f32x4*)(outCS + (size_t)(b * 2 + 1) * DFF + ch) = acc[hh][0][3][n]; }
            }
        }
    }
};

__device__ __forceinline__ void prep_tile(const float* src, int ldsrc, int k0, int n0, bf16_t* dst, int lddst, int dstrow0, int dstk0, LAS float* T) {
    const int tid = ltid();
#pragma unroll
    for (int i = 0; i < 2; ++i) { const int idx = tid + 512 * i, kk = idx >> 4, c4 = (idx & 15) * 4;
        const f32x4 v = *(const f32x4*)(src + (size_t)(k0 + kk) * ldsrc + n0 + c4);
        T[kk * 65 + c4] = v[0]; T[kk * 65 + c4 + 1] = v[1]; T[kk * 65 + c4 + 2] = v[2]; T[kk * 65 + c4 + 3] = v[3]; }
    __syncthreads();
    { const int nn = tid >> 3, kc = (tid & 7) * 8; f32x4 a, b;
#pragma unroll
      for (int i = 0; i < 4; ++i) { a[i] = T[(kc + i) * 65 + nn]; b[i] = T[(kc + 4 + i) * 65 + nn]; }
      *(u32x4*)(dst + (size_t)(dstrow0 + nn) * lddst + dstk0 + kc) = pack8(a, b); }
    __syncthreads();
}
__device__ __forceinline__ void prep_wpb(const float* wp, const float* ps, const float* wb, int g, int n0, bf16_t* WbrT, LAS float* T) {
    const int tid = ltid(); LAS float* TA = T; LAS float* TB = T + 64 * 65;
#pragma unroll
    for (int i = 0; i < 2; ++i) { const int idx = tid + 512 * i, kk = idx >> 4, c4 = (idx & 15) * 4;
        const f32x4 va = *(const f32x4*)(wp + (size_t)(g * 64 + kk) * 64 + c4), sc = *(const f32x4*)(ps + g * 64 + c4);
        const f32x4 vb = *(const f32x4*)(wb + (size_t)(g * 64 + kk) * 1024 + n0 + c4);
#pragma unroll
        for (int j = 0; j < 4; ++j) { TA[kk * 65 + c4 + j] = va[j] * sc[j]; TB[kk * 65 + c4 + j] = vb[j]; } }
    __syncthreads();
    { const int nn = tid >> 3, dc = (tid & 7) * 8; f32x4 a = {0.f, 0.f, 0.f, 0.f}, b = {0.f, 0.f, 0.f, 0.f};
      for (int e = 0; e < 64; ++e) { const float bv = TB[e * 65 + nn];
#pragma unroll
          for (int i = 0; i < 4; ++i) { a[i] += TA[(dc + i) * 65 + e] * bv; b[i] += TA[(dc + 4 + i) * 65 + e] * bv; } }
      *(u32x4*)(WbrT + (size_t)(n0 + nn) * 1024 + 512 + g * 64 + dc) = pack8(a, b); }
    __syncthreads();
}
__device__ __forceinline__ void rms_row_to_bf16(const float* xrow, const float* gain, bf16_t* dst, int lane) {
    f32x4 v[4]; float s = 0.f;
#pragma unroll
    for (int i = 0; i < 2; ++i) { v[2 * i] = *(const f32x4*)(xrow + lane * 8 + 512 * i); v[2 * i + 1] = *(const f32x4*)(xrow + lane * 8 + 512 * i + 4); }
#pragma unroll
    for (int i = 0; i < 4; ++i) s += (v[i][0] * v[i][0] + v[i][1] * v[i][1]) + (v[i][2] * v[i][2] + v[i][3] * v[i][3]);
    s = wave_sum(s); const float inv = rsqrtf(s * (1.0f / 1024.0f) + EPSV);
#pragma unroll
    for (int i = 0; i < 2; ++i) { const f32x4 g0 = *(const f32x4*)(gain + lane * 8 + 512 * i), g1 = *(const f32x4*)(gain + lane * 8 + 512 * i + 4);
        *(u32x4*)(dst + lane * 8 + 512 * i) = pack8(v[2 * i] * inv * g0, v[2 * i + 1] * inv * g1); }
}

__device__ __forceinline__ void phase_prep(KP p, LAS unsigned char* lds) {
    unsigned char* ws = p->ws; LAS float* T = (LAS float*)lds;
    bf16_t* WinT = (bf16_t*)(ws + WS_WIN); bf16_t* WkvT = (bf16_t*)(ws + WS_WKV); bf16_t* WbrT = (bf16_t*)(ws + WS_WBR); bf16_t* WoutT = (bf16_t*)(ws + WS_WOUT);
    bf16_t* WupT = (bf16_t*)(ws + WS_WUP); bf16_t* WdownT = (bf16_t*)(ws + WS_WDOWN); bf16_t* WsT = (bf16_t*)(ws + WS_WST);
    const int G = gridDim.x, tid = ltid(), lane = tid & 63, wid = tid >> 6;
    for (int row = blockIdx.x * 8 + wid; row < MT + 2048; row += G * 8) {
        if (row < MT) { const float* xr = row < NPROMPT ? p->in[0] + (size_t)row * 1024 : p->in[1] + (size_t)(row - NPROMPT) * 1024;
            rms_row_to_bf16(xr, p->in[7], (bf16_t*)(ws + WS_R1) + (size_t)row * 1024, lane); }
        else { const int r = row - MT; rms_row_to_bf16(p->in[2] + (size_t)r * 1024, p->in[19], (bf16_t*)(ws + WS_MEMN) + (size_t)r * 1024, lane); }
    }
    for (int i = blockIdx.x * 512 + tid; i < 4 * 128 * 128; i += G * 512) { const int t = (i >> 7) & 127, s = i & 127; WsT[i] = (s <= t) ? f2bf(p->in[15][i]) : (bf16_t)0; }
    constexpr int J0 = 16 * 72, J1 = J0 + 16 * 8, J2 = J1 + 16 * 16, J3 = J2 + 16 * 88, J4 = J3 + 44 * 16, J5 = J4 + 8 * 16, J6 = J5 + 4 * 16, J7 = J6 + 4 * 16;
    for (int job = blockIdx.x; job < J7; job += G) {
        if (job < J0) { const int kt = job / 72, nt = job % 72; prep_tile(p->in[11], DIN, kt * 64, nt * 64, WinT, 1024, nt * 64, kt * 64, T); }
        else if (job < J1) { const int j = job - J0, kt = j / 8, nt = j % 8; prep_tile(p->in[20], 512, kt * 64, nt * 64, WkvT, 1024, nt * 64, kt * 64, T); }
        else if (job < J2) { const int j = job - J1, kt = j / 16, nt = j % 16; prep_tile(p->in[24], 1024, kt * 64, nt * 64, WoutT, 1024, nt * 64, kt * 64, T); }
        else if (job < J3) { const int j = job - J2, kt = j / 88, nt = j % 88; const int n0 = nt * 64; const int cc = n0 < DFF ? n0 : n0 - DFF;
            const int drow = (cc >> 7) * 256 + (n0 < DFF ? 0 : 128) + (cc & 127); prep_tile(p->in[25], NUP, kt * 64, n0, WupT, 1024, drow, kt * 64, T); }
        else if (job < J4) { const int j = job - J3, kt = j / 16, nt = j % 16; prep_tile(p->in[28], 1024, kt * 64, nt * 64, WdownT, DFF, nt * 64, kt * 64, T); }
        else if (job < J5) { const int j = job - J4, kt = j / 16, nt = j % 16; prep_tile(p->in[21], 1024, kt * 64, nt * 64, WbrT, 1024, nt * 64, kt * 64, T); }
        else if (job < J6) { const int j = job - J5, kt = j / 16, nt = j % 16; prep_tile(p->in[23], 1024, kt * 64, nt * 64, WbrT, 1024, nt * 64, 768 + kt * 64, T); }
        else { const int j = job - J6, g = j / 16, nt = j % 16; prep_wpb(p->in[17], p->in[18], p->in[22], g, nt * 64, WbrT, T); }
    }
}

__device__ __forceinline__ void mixA_prompt(KP p, int item, LAS unsigned char* lds) {
    const int tid = ltid(), lane = tid & 63, wid = tid >> 6, fr = lane & 15, fq = lane >> 4;
    const int g = item & 3, tok0 = (item >> 2) * 128;
    const bf16_t* UV = (const bf16_t*)(p->ws + WS_R2); bf16_t* ABC = (bf16_t*)(p->ws + WS_R1); const bf16_t* WsT = (const bf16_t*)(p->ws + WS_WST);
    LAS bf16_t* vnT = (LAS bf16_t*)lds;
    { const int row = tid >> 2, part = tid & 3; const bf16_t* vrow = UV + (size_t)(tok0 + row) * 1024 + 512;
      float s = 0.f, q = 0.f;
#pragma unroll 4
      for (int i = 0; i < 16; ++i) { const u32x4 w = *(const u32x4*)(vrow + part * 128 + i * 8); f32x4 a, b; unpack8(w, a, b);
          s += (a[0] + a[1]) + (a[2] + a[3]) + (b[0] + b[1]) + (b[2] + b[3]);
          q += (a[0] * a[0] + a[1] * a[1]) + (a[2] * a[2] + a[3] * a[3]) + (b[0] * b[0] + b[1] * b[1]) + (b[2] * b[2] + b[3] * b[3]); }
      s += __shfl_xor(s, 1); s += __shfl_xor(s, 2); q += __shfl_xor(q, 1); q += __shfl_xor(q, 2);
      const float mean = s * (1.0f / 512.0f), var = fmaxf(q * (1.0f / 512.0f) - mean * mean, 0.f), rstd = rsqrtf(var + EPSV);
#pragma unroll
      for (int i = 0; i < 4; ++i) { const int d0 = part * 32 + i * 8; const u32x4 w = *(const u32x4*)(vrow + g * 128 + d0); f32x4 a, b; unpack8(w, a, b);
          const f32x4 g0 = *(const f32x4*)(p->in[13] + g * 128 + d0), g1 = *(const f32x4*)(p->in[13] + g * 128 + d0 + 4);
          const f32x4 b0 = *(const f32x4*)(p->in[14] + g * 128 + d0), b1 = *(const f32x4*)(p->in[14] + g * 128 + d0 + 4);
          a = (a - mean) * rstd * g0 + b0; b = (b - mean) * rstd * g1 + b1;
#pragma unroll
          for (int j = 0; j < 4; ++j) { vnT[(d0 + j) * 136 + row] = f2bf(a[j]); vnT[(d0 + 4 + j) * 136 + row] = f2bf(b[j]); } } }
    __syncthreads();
    { f32x4 acc[8];
#pragma unroll
      for (int nb = 0; nb < 8; ++nb) acc[nb] = (f32x4){0.f, 0.f, 0.f, 0.f};
      const int nks = (wid >> 1) + 1;
      for (int ks = 0; ks < nks; ++ks) {
          const bf16x8 wf = *(const bf16x8*)(WsT + (size_t)g * 16384 + (16 * wid + fr) * 128 + ks * 32 + fq * 8);
#pragma unroll
          for (int nb = 0; nb < 8; ++nb) { const bf16x8 vf = *(const LAS bf16x8*)(vnT + (nb * 16 + fr) * 136 + ks * 32 + fq * 8);
              acc[nb] = __builtin_amdgcn_mfma_f32_16x16x32_bf16(vf, wf, acc[nb], 0, 0, 0); } }
      const int t = 16 * wid + fr; const size_t tok = (size_t)tok0 + t; const float bias = p->in[16][g * 128 + t];
#pragma unroll
      for (int nb = 0; nb < 8; ++nb) { const int ch = g * 128 + nb * 16 + fq * 4; const f32x4 uu = unpack4(*(const u32x2*)(UV + tok * 1024 + ch));
          *(u32x2*)(ABC + tok * 1024 + ch) = pack4(uu * (acc[nb] + bias)); } }
    __syncthreads();
}

__device__ __forceinline__ void mixC_prompt(KP p, int item) {
    const int tid = ltid(), lane = tid & 63, wid = tid >> 6, fr = lane & 15, fq = lane >> 4;
    const int h = item & 3, bc = item >> 2, b = bc >> 4, tok0 = bc * 128;
    const bf16_t* Q = (const bf16_t*)(p->ws + WS_Q); const bf16_t* KB = (const bf16_t*)(p->ws + WS_KB); const bf16_t* VT = (const bf16_t*)(p->ws + WS_VT); bf16_t* ABC = (bf16_t*)(p->ws + WS_R1);
    const size_t qrow = (size_t)tok0 + 16 * wid + fr;
    const bf16x8 q0 = *(const bf16x8*)(Q + qrow * 256 + h * 64 + fq * 8), q1 = *(const bf16x8*)(Q + qrow * 256 + h * 64 + 32 + fq * 8);
    f32x4 s[16];
#pragma unroll
    for (int kb = 0; kb < 16; ++kb) { const bf16_t* kp = KB + (size_t)(b * 256 + kb * 16 + fr) * 256 + h * 64 + fq * 8;
        const bf16x8 k0 = *(const bf16x8*)kp, k1 = *(const bf16x8*)(kp + 32);
        s[kb] = __builtin_amdgcn_mfma_f32_16x16x32_bf16(k0, q0, (f32x4){0.f, 0.f, 0.f, 0.f}, 0, 0, 0);
        s[kb] = __builtin_amdgcn_mfma_f32_16x16x32_bf16(k1, q1, s[kb], 0, 0, 0); }
    float mx = -3.0e38f;
#pragma unroll
    for (int kb = 0; kb < 16; ++kb) mx = fmaxf(mx, fmaxf(fmaxf(s[kb][0], s[kb][1]), fmaxf(s[kb][2], s[kb][3])));
    mx = fmaxf(mx, __shfl_xor(mx, 16)); mx = fmaxf(mx, __shfl_xor(mx, 32));
    float sum = 0.f;
#pragma unroll
    for (int kb = 0; kb < 16; ++kb) {
#pragma unroll
        for (int j = 0; j < 4; ++j) { const float e = __builtin_amdgcn_exp2f((s[kb][j] - mx) * 1.442695041f); s[kb][j] = e; sum += e; } }
    sum += __shfl_xor(sum, 16); sum += __shfl_xor(sum, 32);
    f32x4 o[4];
#pragma unroll
    for (int db = 0; db < 4; ++db) o[db] = (f32x4){0.f, 0.f, 0.f, 0.f};
#pragma unroll
    for (int kk = 0; kk < 8; ++kk) { const u32x4 pw = pack8(s[2 * kk], s[2 * kk + 1]); const bf16x8 pf = __builtin_bit_cast(bf16x8, pw);
#pragma unroll
        for (int db = 0; db < 4; ++db) { const bf16_t* vp = VT + ((size_t)((b * 4 + h) * 64 + db * 16 + fr)) * 256 + kk * 32 + fq * 4;
            const u32x2 v0 = *(const u32x2*)vp, v1 = *(const u32x2*)(vp + 16); u32x4 vw; vw[0] = v0[0]; vw[1] = v0[1]; vw[2] = v1[0]; vw[3] = v1[1];
            o[db] = __builtin_amdgcn_mfma_f32_16x16x32_bf16(__builtin_bit_cast(bf16x8, vw), pf, o[db], 0, 0, 0); } }
    const float inv = 1.0f / sum;
#pragma unroll
    for (int db = 0; db < 4; ++db) *(u32x2*)(ABC + qrow * 1024 + 768 + h * 64 + db * 16 + fq * 4) = pack4(o[db] * inv);
}

__device__ __forceinline__ void mixB_prompt(KP p, int item) {
    const int tid = ltid(), ch = tid & 255, half = tid >> 8, g = ch >> 6, w = 2 << g;
    const int b = item >> 4, c = item & 15, pos0 = c * 128 + half * 64; const size_t tb = (size_t)b * 2048;
    const float* BP = (const float*)(p->ws + WS_BP); bf16_t* ABC = (bf16_t*)(p->ws + WS_R1); float* outP = p->out + O_POOLP;
    float S = 0.f;
    for (int i = 1; i <= w; ++i) { const int ps = pos0 - i; if (ps >= 0) S += BP[(tb + ps) * 256 + ch]; }
    for (int r = 0; r < 64; ++r) { const int pos = pos0 + r; const float xv = BP[(tb + pos) * 256 + ch];
        S += xv; if (pos - w >= 0) S -= BP[(tb + pos - w) * 256 + ch];
        const int cnt = (pos + 1 < w) ? pos + 1 : w;
        ABC[(tb + pos) * 1024 + 512 + ch] = f2bf(S / (float)cnt - xv);
        if (pos >= 2033) outP[(size_t)(b * 15 + pos - 2033) * 256 + ch] = xv; }
}

__device__ __forceinline__ void mix_sample(KP p, int b, LAS unsigned char* lds) {
    const int tid = ltid(), lane = tid & 63, wid = tid >> 6;
    const bf16_t* UV = (const bf16_t*)(p->ws + WS_R2); bf16_t* ABC = (bf16_t*)(p->ws + WS_R1); const float* BP = (const float*)(p->ws + WS_BP); const bf16_t* Q = (const bf16_t*)(p->ws + WS_Q);
    LAS float* red = (LAS float*)lds;
    LAS float* qs = (LAS float*)(lds + 1024);
    LAS float* ps = (LAS float*)(lds + 8192);
    const size_t tokS = (size_t)NPROMPT + b * 4;
    { const int ch = tid; float v0 = bf2f(UV[(tokS + 0) * 1024 + 512 + ch]), v1 = bf2f(UV[(tokS + 1) * 1024 + 512 + ch]), v2 = bf2f(UV[(tokS + 2) * 1024 + 512 + ch]), v3 = bf2f(UV[(tokS + 3) * 1024 + 512 + ch]);
      float r0 = wave_sum(v0), r1 = wave_sum(v1), r2 = wave_sum(v2), r3 = wave_sum(v3), r4 = wave_sum(v0 * v0), r5 = wave_sum(v1 * v1), r6 = wave_sum(v2 * v2), r7 = wave_sum(v3 * v3);
      if (lane == 0) { red[wid * 8 + 0] = r0; red[wid * 8 + 1] = r1; red[wid * 8 + 2] = r2; red[wid * 8 + 3] = r3; red[wid * 8 + 4] = r4; red[wid * 8 + 5] = r5; red[wid * 8 + 6] = r6; red[wid * 8 + 7] = r7; }
      for (int i = tid; i < 1024; i += 512) qs[i] = bf2f(Q[(tokS + (i >> 8)) * 256 + (i & 255)]);
      __syncthreads();
      float sm[8];
#pragma unroll
      for (int k = 0; k < 8; ++k) { float a = 0.f;
#pragma unroll
          for (int w8 = 0; w8 < 8; ++w8) a += red[w8 * 8 + k]; sm[k] = a; }
      const float lg = p->in[13][ch], lb = p->in[14][ch];
      float vn[4]; const float vv[4] = {v0, v1, v2, v3};
#pragma unroll
      for (int t = 0; t < 4; ++t) { const float mean = sm[t] * (1.0f / 512.0f), var = fmaxf(sm[4 + t] * (1.0f / 512.0f) - mean * mean, 0.f);
          vn[t] = (vv[t] - mean) * rsqrtf(var + EPSV) * lg + lb; p->out[O_VS + (size_t)(b * 4 + t) * 512 + ch] = vn[t]; }
      const int g = ch >> 7; const float* wsp = p->in[15] + (size_t)g * 16384; const float* bsp = p->in[16] + g * 128;
#pragma unroll
      for (int t = 0; t < 4; ++t) { float sg = bsp[t];
#pragma unroll
          for (int s = 0; s <= t; ++s) sg += wsp[t * 128 + s] * vn[s];
          const float uu = bf2f(UV[(tokS + t) * 1024 + ch]); ABC[(tokS + t) * 1024 + ch] = f2bf(uu * sg); } }
    if (tid < 256) { const int ch = tid, g = ch >> 6, w = 2 << g; const float* sp = p->in[5] + (size_t)b * 15 * 256; float* outS = p->out + O_POOLS + (size_t)b * 15 * 256;
        for (int t = 0; t < 4; ++t) { float S = 0.f;
            for (int i = 0; i < w; ++i) { const int e = 15 + t - i; S += (e < 15) ? sp[e * 256 + ch] : BP[(tokS + e - 15) * 256 + ch]; }
            const float xv = BP[(tokS + t) * 256 + ch]; ABC[(tokS + t) * 1024 + 512 + ch] = f2bf(S / (float)w - xv); }
        for (int j = 0; j < 15; ++j) outS[j * 256 + ch] = (j < 11) ? sp[(4 + j) * 256 + ch] : BP[(tokS + j - 11) * 256 + ch]; }
    { const int h = wid >> 1, t0 = 2 * (wid & 1); const float* ck = p->in[3] + (size_t)b * 256 * 256 + h * 64; const float* cv = p->in[4] + (size_t)b * 256 * 256 + h * 64;
      float s0[4], s1[4];
#pragma unroll
      for (int i = 0; i < 4; ++i) { const float* kr = ck + (size_t)(lane + 64 * i) * 256; float a0 = 0.f, a1 = 0.f;
#pragma unroll 4
          for (int d4 = 0; d4 < 16; ++d4) { const f32x4 kv = *(const f32x4*)(kr + d4 * 4);
              const f32x4 qa = *(const LAS f32x4*)(qs + t0 * 256 + h * 64 + d4 * 4), qb = *(const LAS f32x4*)(qs + (t0 + 1) * 256 + h * 64 + d4 * 4);
              a0 += kv[0] * qa[0] + kv[1] * qa[1] + kv[2] * qa[2] + kv[3] * qa[3]; a1 += kv[0] * qb[0] + kv[1] * qb[1] + kv[2] * qb[2] + kv[3] * qb[3]; }
          s0[i] = a0; s1[i] = a1; }
      const float m0 = wave_max(fmaxf(fmaxf(s0[0], s0[1]), fmaxf(s0[2], s0[3]))), m1 = wave_max(fmaxf(fmaxf(s1[0], s1[1]), fmaxf(s1[2], s1[3])));
      float e0 = 0.f, e1 = 0.f;
#pragma unroll
      for (int i = 0; i < 4; ++i) { s0[i] = __builtin_amdgcn_exp2f((s0[i] - m0) * 1.442695041f); s1[i] = __builtin_amdgcn_exp2f((s1[i] - m1) * 1.442695041f); e0 += s0[i]; e1 += s1[i]; }
      e0 = 1.0f / wave_sum(e0); e1 = 1.0f / wave_sum(e1);
#pragma unroll
      for (int i = 0; i < 4; ++i) { ps[(wid * 2 + 0) * 256 + lane + 64 * i] = s0[i] * e0; ps[(wid * 2 + 1) * 256 + lane + 64 * i] = s1[i] * e1; }
      __syncthreads();
      float o0 = 0.f, o1 = 0.f;
#pragma unroll 2
      for (int m4 = 0; m4 < 64; ++m4) { const f32x4 pa = *(const LAS f32x4*)(ps + (wid * 2 + 0) * 256 + m4 * 4), pb = *(const LAS f32x4*)(ps + (wid * 2 + 1) * 256 + m4 * 4);
#pragma unroll
          for (int j = 0; j < 4; ++j) { const float vv = cv[(size_t)(m4 * 4 + j) * 256 + lane]; o0 += pa[j] * vv; o1 += pb[j] * vv; } }
      ABC[(tokS + t0) * 1024 + 768 + h * 64 + lane] = f2bf(o0); ABC[(tokS + t0 + 1) * 1024 + 768 + h * 64 + lane] = f2bf(o1); }
    __syncthreads();
}

#ifndef PH
#define PH 0x3ff
#endif
#define XB_TMO      128
#define XB_XCNT(j)  (256  + 64 * (j))
#define XB_XSUB(j)  (1280 + 64 * (j))
#define XB_XGEN(j)  (2304 + 64 * (j))
#define XB_TOP      3328
#define XB_TOPGEN   3392
#define XCD_BAR_WORDS 3456
#define XB_SPIN_CAP (1u << 18)

__device__ __forceinline__ unsigned xb_ld(unsigned* p)              { return __hip_atomic_load(p, __ATOMIC_RELAXED, __HIP_MEMORY_SCOPE_AGENT); }
__device__ __forceinline__ unsigned xb_add(unsigned* p, unsigned v) { return __hip_atomic_fetch_add(p, v, __ATOMIC_RELAXED, __HIP_MEMORY_SCOPE_AGENT); }
__device__ __forceinline__ unsigned xb_xcc_id() { return (unsigned)__builtin_amdgcn_s_getreg((3 << 11) | 20) & 0xFu; }
#define XB_SPIN(cond, bar) do { unsigned _sp = 0; while (cond) { __builtin_amdgcn_s_sleep(1); \
    if ((++_sp & 255u) == 0u) { if (xb_ld(&(bar)[XB_TMO])) break; if (_sp > XB_SPIN_CAP) { atomicAdd(&(bar)[XB_TMO], 1u); break; } } } } while (0)

struct XcdBarrier {
    unsigned* bar; unsigned x;
    volatile LAS unsigned* st;
};

__device__ __forceinline__ XcdBarrier xcd_barrier_post(unsigned* bar, volatile LAS unsigned* st) {
    XcdBarrier b; b.bar = bar; b.x = xb_xcc_id(); b.st = st;
    if (threadIdx.x == 0) (void)xb_add(&bar[XB_XCNT(b.x)], 1u);
    return b;
}
__device__ __forceinline__ void xcd_barrier_complete(unsigned* bar, unsigned x, unsigned& nloc, unsigned& nx) {
    const unsigned G = gridDim.x * gridDim.y * gridDim.z;
    unsigned sum, cnt, mine, sp = 0u;
    for (;;) {
        sum = 0u; cnt = 0u; mine = 0u;
#pragma unroll
        for (unsigned j = 0; j < 16; ++j) { const unsigned c = xb_ld(&bar[XB_XCNT(j)]); sum += c; cnt += (c > 0u) ? 1u : 0u; mine = (j == x) ? c : mine; }
        if (sum == G) break;
        __builtin_amdgcn_s_sleep(1);
        if ((++sp & 255u) == 0u) { if (xb_ld(&bar[XB_TMO])) break; if (sp > XB_SPIN_CAP) { atomicAdd(&bar[XB_TMO], 1u); break; } }
    }
    nloc = mine > 0u ? mine : 1u; nx = cnt > 0u ? cnt : 1u;
}

__device__ __forceinline__ void xcd_barrier(const XcdBarrier& b) {
    asm volatile("s_waitcnt vmcnt(0)" ::: "memory");
    __syncthreads();
    if (threadIdx.x == 0) {
        unsigned* bar = b.bar;
        __builtin_amdgcn_s_waitcnt(0);
        unsigned nloc = b.st[0], nx = b.st[1];
        if (nloc == 0u) { xcd_barrier_complete(bar, b.x, nloc, nx); b.st[0] = nloc; b.st[1] = nx; }
        const unsigned old = xb_add(&bar[XB_XSUB(b.x)], 1u);
        const unsigned gen = old / nloc;
        if (old + 1u == (gen + 1u) * nloc) {
            __builtin_amdgcn_fence(__ATOMIC_RELEASE, "agent");
            asm volatile("s_waitcnt vmcnt(0)" ::: "memory");
            const unsigned og = xb_add(&bar[XB_TOP], 1u);
            const unsigned tg = og / nx;
            if (og + 1u == (tg + 1u) * nx) xb_add(&bar[XB_TOPGEN], 1u);
            else XB_SPIN(xb_ld(&bar[XB_TOPGEN]) == tg, bar);
            __builtin_amdgcn_fence(__ATOMIC_ACQUIRE, "agent");
            xb_add(&bar[XB_XGEN(b.x)], 1u);
            asm volatile("s_waitcnt vmcnt(0)" ::: "memory");
        } else {
            XB_SPIN(xb_ld(&bar[XB_XGEN(b.x)]) == gen, bar);
            __builtin_amdgcn_fence(__ATOMIC_ACQUIRE, "agent");
            asm volatile("s_waitcnt vmcnt(0)" ::: "memory");
        }
    }
    __syncthreads();
}
__global__ void __launch_bounds__(512) mega_fwd(Params p_unused) {
    extern __shared__ __attribute__((aligned(16))) unsigned char lds_raw[];
    LAS unsigned char* lds = (LAS unsigned char*)lds_raw;
    const int G = gridDim.x, bx = blockIdx.x;
    { volatile LAS unsigned* st0 = (volatile LAS unsigned*)(lds + 131072 + 4096); if (threadIdx.x < 4) st0[threadIdx.x] = 0u; }
    __syncthreads();
    XcdBarrier xb = xcd_barrier_post((unsigned*)(get_params()->ws + WS_BAR), (volatile LAS unsigned*)(lds + 131072 + 4096));
    cg::this_grid().sync();

#if PH & 1
    { KP p = get_params(); unsigned char* ws = p->ws;
    phase_prep(p, lds);
    }
#endif
    xcd_barrier(xb);

#if PH & 2
    { KP p = get_params(); unsigned char* ws = p->ws;
    { Gemm g{(const bf16_t*)(ws + WS_R1), (const bf16_t*)(ws + WS_WIN), MT, DIN, 1024}; StaticOrder S; S.init(MT, DIN, G, bx);
      EpiG1 E{(bf16_t*)(ws + WS_R2), (float*)(ws + WS_BP), (bf16_t*)(ws + WS_Q), (bf16_t*)(ws + WS_R3), p->in[12]};
      gemm_phase(lds, g, S, E);
      Gemm g2{(const bf16_t*)(ws + WS_MEMN), (const bf16_t*)(ws + WS_WKV), 2048, 512, 1024}; StaticOrder S2; S2.init(2048, 512, G, G - 1 - bx);
      EpiKV E2{p->out + O_MK, p->out + O_MV, (bf16_t*)(ws + WS_KB), (bf16_t*)(ws + WS_VT)};
      gemm_phase(lds, g2, S2, E2); }
    }
#endif
    xcd_barrier(xb);

#if PH & 4
    { KP p = get_params(); unsigned char* ws = p->ws;
    for (int it = bx; it < 512; it += G) mixA_prompt(p, it, lds);
    for (int it = bx; it < 512; it += G) mixC_prompt(p, it);
    for (int it = bx; it < 128; it += G) mixB_prompt(p, it);
    for (int it = G - 1 - bx; it < 128; it += G) mix_sample(p, it, lds);
    }
#endif
    xcd_barrier(xb);

#if PH & 8
    { KP p = get_params(); unsigned char* ws = p->ws;
    { Gemm g{(const bf16_t*)(ws + WS_R1), (const bf16_t*)(ws + WS_WBR), MT, 1024, 1024}; StaticOrder S; S.init(MT, 1024, G, bx);
      EpiG2 E{(const bf16_t*)(ws + WS_R3), (bf16_t*)(ws + WS_R2)};
      gemm_phase(lds, g, S, E); }
    }
#endif
    xcd_barrier(xb);

#if PH & 16
    { KP p = get_params(); unsigned char* ws = p->ws;
    { Gemm g{(const bf16_t*)(ws + WS_R2), (const bf16_t*)(ws + WS_WOUT), MT, 1024, 1024}; StaticOrder S; S.init(MT, 1024, G, bx);
      EpiSS E{(float*)(ws + WS_R3), (float*)(ws + WS_SS1)};
      gemm_phase(lds, g, S, E); }
    }
#endif
    xcd_barrier(xb);

#if PH & 32
    { KP p = get_params(); unsigned char* ws = p->ws;
    { const int tid = ltid(), lane = tid & 63, wid = tid >> 6; const float* MIX = (const float*)(ws + WS_R3); const float* SS1 = (const float*)(ws + WS_SS1); bf16_t* HN = (bf16_t*)(ws + WS_R1);
      for (int row = bx * 8 + wid; row < MT; row += G * 8) {
          const float* xr = row < NPROMPT ? p->in[0] + (size_t)row * 1024 : p->in[1] + (size_t)(row - NPROMPT) * 1024;
          const f32x4 s0 = *(const f32x4*)(SS1 + (size_t)row * 16), s1 = *(const f32x4*)(SS1 + (size_t)row * 16 + 4), s2 = *(const f32x4*)(SS1 + (size_t)row * 16 + 8), s3 = *(const f32x4*)(SS1 + (size_t)row * 16 + 12);
          const float ss = ((s0[0] + s0[1]) + (s0[2] + s0[3])) + ((s1[0] + s1[1]) + (s1[2] + s1[3])) + ((s2[0] + s2[1]) + (s2[2] + s2[3])) + ((s3[0] + s3[1]) + (s3[2] + s3[3]));
          const float inv = rsqrtf(ss * (1.0f / 1024.0f) + EPSV);
          f32x4 hv[4]; float hs = 0.f;
#pragma unroll
          for (int i = 0; i < 4; ++i) { const int c = lane * 8 + 512 * (i >> 1) + 4 * (i & 1);
              const f32x4 mv = *(const f32x4*)(MIX + (size_t)row * 1024 + c), xv = *(const f32x4*)(xr + c), gp = *(const f32x4*)(p->in[8] + c);
              hv[i] = xv + mv * inv * gp; *(f32x4*)(p->out + O_Y + (size_t)row * 1024 + c) = hv[i];
              hs += (hv[i][0] * hv[i][0] + hv[i][1] * hv[i][1]) + (hv[i][2] * hv[i][2] + hv[i][3] * hv[i][3]); }
          hs = wave_sum(hs); const float inv2 = rsqrtf(hs * (1.0f / 1024.0f) + EPSV);
#pragma unroll
          for (int i = 0; i < 2; ++i) { const int c = lane * 8 + 512 * i; const f32x4 g0 = *(const f32x4*)(p->in[9] + c), g1 = *(const f32x4*)(p->in[9] + c + 4);
              *(u32x4*)(HN + (size_t)row * 1024 + c) = pack8(hv[2 * i] * inv2 * g0, hv[2 * i + 1] * inv2 * g1); } } }
    }
#endif
    xcd_barrier(xb);

#if PH & 64
    { KP p = get_params(); unsigned char* ws = p->ws;
    { Gemm g{(const bf16_t*)(ws + WS_R1), (const bf16_t*)(ws + WS_WUP), MT, NUP, 1024}; StaticOrder S; S.init(MT, NUP, G, bx);
      EpiG4 E{(bf16_t*)(ws + WS_R3), (float*)(ws + WS_GRAW), (float*)(ws + WS_URAW), p->in[26], p->in[27], p->in[6], p->out + O_CONVP, p->out + O_CONVS};
      gemm_phase(lds, g, S, E); }
    }
#endif
    xcd_barrier(xb);

#if PH & 128
    { KP p = get_params(); unsigned char* ws = p->ws;
    { const int tid = ltid(); const float* GRAW = (const float*)(ws + WS_GRAW); const float* URAW = (const float*)(ws + WS_URAW); bf16_t* Y = (bf16_t*)(ws + WS_R3);
      const float* cw = p->in[26]; const float* cb = p->in[27];
      for (int idx = bx * 512 + tid; idx < 128 * 2 * DFF; idx += G * 512) {
          const int seg = idx / (2 * DFF), rem = idx - seg * 2 * DFF, j = rem / DFF, ch = rem - j * DFF; const bool first = (seg & 15) == 0;
          float gm2, gm1, g0;
          if (j == 0) { gm2 = first ? 0.f : GRAW[(size_t)((seg - 1) * 4 + 0) * DFF + ch]; gm1 = first ? 0.f : GRAW[(size_t)((seg - 1) * 4 + 1) * DFF + ch]; g0 = GRAW[(size_t)(seg * 4 + 2) * DFF + ch]; }
          else { gm2 = first ? 0.f : GRAW[(size_t)((seg - 1) * 4 + 1) * DFF + ch]; gm1 = GRAW[(size_t)(seg * 4 + 2) * DFF + ch]; g0 = GRAW[(size_t)(seg * 4 + 3) * DFF + ch]; }
          const float c = cb[ch] + cw[ch] * gm2 + cw[DFF + ch] * gm1 + cw[2 * DFF + ch] * g0;
          Y[((size_t)seg * 128 + j) * DFF + ch] = f2bf(gelu1(c) * URAW[(size_t)(seg * 2 + j) * DFF + ch]); } }
    }
#endif
    xcd_barrier(xb);

#if PH & 256
    { KP p = get_params(); unsigned char* ws = p->ws;
    { Gemm g{(const bf16_t*)(ws + WS_R3), (const bf16_t*)(ws + WS_WDOWN), MT, 1024, DFF}; StaticOrder S; S.init(MT, 1024, G, bx);
      EpiSS E{(float*)(ws + WS_R1), (float*)(ws + WS_SS2)};
      gemm_phase(lds, g, S, E); }
    }
#endif
    xcd_barrier(xb);

#if PH & 512
    { KP p = get_params(); unsigned char* ws = p->ws;
    { const int tid = ltid(), lane = tid & 63, wid = tid >> 6; const float* F = (const float*)(ws + WS_R1); const float* SS2 = (const float*)(ws + WS_SS2);
      for (int row = bx * 8 + wid; row < MT; row += G * 8) {
          const f32x4 s0 = *(const f32x4*)(SS2 + (size_t)row * 16), s1 = *(const f32x4*)(SS2 + (size_t)row * 16 + 4), s2 = *(const f32x4*)(SS2 + (size_t)row * 16 + 8), s3 = *(const f32x4*)(SS2 + (size_t)row * 16 + 12);
          const float ss = ((s0[0] + s0[1]) + (s0[2] + s0[3])) + ((s1[0] + s1[1]) + (s1[2] + s1[3])) + ((s2[0] + s2[1]) + (s2[2] + s2[3])) + ((s3[0] + s3[1]) + (s3[2] + s3[3]));
          const float inv = rsqrtf(ss * (1.0f / 1024.0f) + EPSV);
#pragma unroll
          for (int i = 0; i < 4; ++i) { const int c = lane * 4 + 256 * i; float* op = p->out + O_Y + (size_t)row * 1024 + c;
              const f32x4 fv = *(const f32x4*)(F + (size_t)row * 1024 + c), hv = *(const f32x4*)op, gp = *(const f32x4*)(p->in[10] + c);
              *(f32x4*)op = hv + fv * inv * gp; } } }
    }
#endif
#ifdef DUMP_OFF
    xcd_barrier(xb);
    { KP p = get_params(); const int tid = ltid();
      if (DUMP_F32) { const float* src = (const float*)(p->ws + DUMP_OFF); for (size_t i = (size_t)bx * 512 + tid; i < (size_t)MT * 1024; i += (size_t)G * 512) p->out[i] = src[i]; }
      else { const bf16_t* src = (const bf16_t*)(p->ws + DUMP_OFF); for (size_t i = (size_t)bx * 512 + tid; i < (size_t)MT * 1024; i += (size_t)G * 512) p->out[i] = bf2f(src[i]); } }
#endif
}

extern "C" void kernel_launch(void* const* d_in, const int* in_sizes, int n_in, void* d_out, int out_size, void* d_ws, size_t ws_size, hipStream_t stream) {
    static int grid = 0;
    if (grid == 0) {
        if (n_in != 29 || ws_size < WS_END) { fprintf(stderr, "kernel_launch: unexpected n_in %d / ws_size %zu (need %zu)\n", n_in, ws_size, (size_t)WS_END); grid = -1; return; }
        int dev = 0, cus = 0, per_cu = 0;
        (void)hipGetDevice(&dev); (void)hipDeviceGetAttribute(&cus, hipDeviceAttributeMultiprocessorCount, dev);
        if (hipFuncSetAttribute((const void*)mega_fwd, hipFuncAttributeMaxDynamicSharedMemorySize, LDS_BYTES) != hipSuccess) fprintf(stderr, "kernel_launch: hipFuncSetAttribute failed\n");
        if (hipOccupancyMaxActiveBlocksPerMultiprocessor(&per_cu, (const void*)mega_fwd, 512, LDS_BYTES) != hipSuccess || per_cu < 1) per_cu = 1;
        (void)hipGetLastError();
        grid = cus * per_cu; if (grid <= 0) grid = 256;
    }
    if (grid < 0) return;
    Params p{};
    for (int i = 0; i < 29; ++i) p.in[i] = (const float*)d_in[i];
    p.out = (float*)d_out; p.ws = (unsigned char*)d_ws;
    (void)hipMemsetAsync((unsigned char*)d_ws + WS_BAR, 0, 16384, stream);
    void* args[] = {&p};
    hipError_t e = hipLaunchCooperativeKernel((const void*)mega_fwd, dim3(grid), dim3(512), args, LDS_BYTES, stream);
    if (e != hipSuccess) fprintf(stderr, "cooperative launch failed: %s (grid %d)\n", hipGetErrorString(e), grid);
}
```

```cpp
#include <hip/hip_runtime.h>
#include <hip/hip_cooperative_groups.h>
#include <cstdio>
namespace cg = cooperative_groups;

#define LAS __attribute__((address_space(3)))
typedef unsigned short bf16_t;
typedef short bf16x8 __attribute__((ext_vector_type(8)));
typedef float f32x4 __attribute__((ext_vector_type(4)));
typedef float f32x2 __attribute__((ext_vector_type(2)));
typedef unsigned u32x4 __attribute__((ext_vector_type(4)));
typedef unsigned u32x2 __attribute__((ext_vector_type(2)));

constexpr int DM = 1024, NPROMPT = 16384, NSAMP = 512, MT = NPROMPT + NSAMP;
constexpr int DIN = 4608, DFF = 2816, NUP = 2 * DFF;
constexpr float EPSV = 1e-6f;
constexpr int LDS_BYTES = 131072 + 8192;

constexpr size_t O_Y = 0, O_MK = 17301504, O_MV = 17825792, O_POOLP = 18350080, O_CONVP = 18380800, O_VS = 18425856, O_POOLS = 18688000, O_CONVS = 19179520;
constexpr size_t WS_WIN = 0, WS_WKV = WS_WIN + 9437184, WS_WBR = WS_WKV + 1048576, WS_WOUT = WS_WBR + 2097152, WS_WUP = WS_WOUT + 2097152,
                 WS_WDOWN = WS_WUP + 11534336, WS_WST = WS_WDOWN + 5767168, WS_R1 = WS_WST + 131072, WS_R2 = WS_R1 + 34603008, WS_R3 = WS_R2 + 34603008,
                 WS_BP = WS_R3 + 103809024, WS_Q = WS_BP + 17301504, WS_MEMN = WS_Q + 8650752, WS_KB = WS_MEMN + 4194304, WS_VT = WS_KB + 1048576,
                 WS_SS1 = WS_VT + 1048576, WS_SS2 = WS_SS1 + 1081344, WS_GRAW = WS_SS2 + 1081344, WS_URAW = WS_GRAW + 5767168, WS_BAR = WS_URAW + 2883584, WS_END = WS_BAR + 16384;

struct Params {
    const float* in[29];
    float* out;
    unsigned char* ws;
};

typedef const __attribute__((address_space(4))) Params* KP;
__device__ __forceinline__ KP get_params() { unsigned long long kp = (unsigned long long)__builtin_amdgcn_kernarg_segment_ptr(); asm volatile("" : "+s"(kp)); return (KP)kp; }
__device__ __forceinline__ int ltid() { int t = threadIdx.x; asm volatile("" : "+v"(t)); return t; }
typedef __bf16 bf16x2_t __attribute__((ext_vector_type(2)));
__device__ __forceinline__ unsigned cvt_pk_bf16(float lo, float hi) { f32x2 v = {lo, hi}; bf16x2_t r = __builtin_convertvector(v, bf16x2_t); return __builtin_bit_cast(unsigned, r); }
__device__ __forceinline__ bf16_t f2bf(float x) { return (bf16_t)(cvt_pk_bf16(x, x) & 0xffffu); }
__device__ __forceinline__ float bf2f(bf16_t b) { return __uint_as_float(((unsigned)b) << 16); }
__device__ __forceinline__ float bflo(unsigned w) { return __uint_as_float(w << 16); }
__device__ __forceinline__ float bfhi(unsigned w) { return __uint_as_float(w & 0xffff0000u); }
__device__ __forceinline__ void unpack8(const u32x4 w, f32x4& a, f32x4& b) {
    a[0] = bflo(w[0]); a[1] = bfhi(w[0]); a[2] = bflo(w[1]); a[3] = bfhi(w[1]);
    b[0] = bflo(w[2]); b[1] = bfhi(w[2]); b[2] = bflo(w[3]); b[3] = bfhi(w[3]);
}
__device__ __forceinline__ f32x4 unpack4(const u32x2 w) { f32x4 a; a[0] = bflo(w[0]); a[1] = bfhi(w[0]); a[2] = bflo(w[1]); a[3] = bfhi(w[1]); return a; }
__device__ __forceinline__ u32x2 pack4(const f32x4 v) { u32x2 w; w[0] = cvt_pk_bf16(v[0], v[1]); w[1] = cvt_pk_bf16(v[2], v[3]); return w; }
__device__ __forceinline__ u32x4 pack8(const f32x4 a, const f32x4 b) { u32x4 w; w[0] = cvt_pk_bf16(a[0], a[1]); w[1] = cvt_pk_bf16(a[2], a[3]); w[2] = cvt_pk_bf16(b[0], b[1]); w[3] = cvt_pk_bf16(b[2], b[3]); return w; }
__device__ __forceinline__ float gelu1(float x) {
    const float u = x * (0.7978845608f + 0.0356774081f * x * x);
    const float e = __builtin_amdgcn_exp2f(-2.885390082f * u);
    return x * __builtin_amdgcn_rcpf(1.0f + e);
}
__device__ __forceinline__ f32x4 gelu4(f32x4 v) { f32x4 o; o[0] = gelu1(v[0]); o[1] = gelu1(v[1]); o[2] = gelu1(v[2]); o[3] = gelu1(v[3]); return o; }
__device__ __forceinline__ float sigm1(float x) { x = fminf(fmaxf(x, -30.f), 30.f); return __builtin_amdgcn_rcpf(1.0f + __builtin_amdgcn_exp2f(-1.442695041f * x)); }
__device__ __forceinline__ float wave_sum(float v) {
    v += __shfl_xor(v, 1); v += __shfl_xor(v, 2); v += __shfl_xor(v, 4); v += __shfl_xor(v, 8); v += __shfl_xor(v, 16); v += __shfl_xor(v, 32); return v;
}
__device__ __forceinline__ float wave_max(float v) {
    v = fmaxf(v, __shfl_xor(v, 1)); v = fmaxf(v, __shfl_xor(v, 2)); v = fmaxf(v, __shfl_xor(v, 4)); v = fmaxf(v, __shfl_xor(v, 8)); v = fmaxf(v, __shfl_xor(v, 16)); v = fmaxf(v, __shfl_xor(v, 32)); return v;
}
__device__ __forceinline__ float dpp_shr1(float v) { return __int_as_float(__builtin_amdgcn_update_dpp(0, __float_as_int(v), 0x111, 0xf, 0xf, true)); }
__device__ __forceinline__ f32x4 dpp_shr1_4(f32x4 v) { f32x4 o; o[0] = dpp_shr1(v[0]); o[1] = dpp_shr1(v[1]); o[2] = dpp_shr1(v[2]); o[3] = dpp_shr1(v[3]); return o; }

constexpr int BM = 256, BK = 64, HALF = 128, HTB = HALF * BK * 2, NXCD = 8, WGM = 8;
__device__ __forceinline__ int lds_byte(int r, int c) { const int st = (r >> 4) * 2 + (c >> 5), rr = r & 15, cc = c & 31, ob = rr * 64 + cc * 2; return st * 1024 + (ob ^ (((ob >> 9) & 1) << 5)); }
__device__ __forceinline__ void stage_rc(int b, int& R, int& C) { const int st = b / 1024, sb = b % 1024, swz = sb ^ (((sb >> 9) & 1) << 5); R = (st >> 1) * 16 + swz / 64; C = (st & 1) * 32 + (swz % 64) / 2; }
__device__ __forceinline__ int perm32(int rho) { const int n = rho >> 4, i = rho & 15; return 8 * (i >> 2) + 4 * n + (i & 3); }

struct Unit { int pm, pn; };
struct Gemm { const bf16_t* A; const bf16_t* Bt; int M, N, K; };
struct StaticOrder {
    int nM, nN, nwg, G, c;
    __device__ void init(int M, int N, int G_, int c_) { nM = M / BM; nN = N / BM; nwg = nM * nN; G = G_; c = c_; }
    __device__ bool next(int i, Unit& u) const {
        const long L = (long)i * G + c; if (L >= nwg || c < 0) return false;
        int wgid = (int)L; { const int q = nwg / NXCD, r = nwg % NXCD, xcd = wgid % NXCD, off = wgid / NXCD; wgid = (xcd < r ? xcd * (q + 1) : r * (q + 1) + (xcd - r) * q) + off; }
        const int nig = WGM * nN, gid = wgid / nig, fm = gid * WGM, gsz = (nM - fm) < WGM ? (nM - fm) : WGM;
        u.pm = fm + ((wgid % nig) % gsz); u.pn = (wgid % nig) / gsz; return true;
    }
};

struct OneUnit { Unit u; __device__ bool next(int i, Unit& o) const { if (i != 0) return false; o = u; return true; } };
template <class Epi, class Sched>
__device__ __forceinline__ void gemm_phase(LAS unsigned char* lds, const Gemm g, const Sched& S, const Epi& E) {
    const int tid = ltid(), wid = __builtin_amdgcn_readfirstlane(tid >> 6), lane = tid & 63, wr = wid >> 2, wc = wid & 3, fr = lane & 15, fq = lane >> 4;
    const int K = g.K, nt = K / BK;
    unsigned voffA[2], voffB[2];
#pragma unroll
    for (int i = 0; i < 2; ++i) { int R, C; stage_rc(tid * 16 + i * 8192, R, C); const int Rb = Epi::PERM ? ((R & ~31) + perm32(R & 31)) : R;
        const int Ra = Epi::PERMA ? (128 * (R >> 6) + 8 * (R & 15) + ((R >> 4) & 3)) : R;
        voffA[i] = (unsigned)(Ra * K + C) * 2u; voffB[i] = (unsigned)(Rb * K + C) * 2u; }
    const size_t kstep = (size_t)(BK * 2);
    const size_t hstep = (size_t)HALF * K * 2;
    const size_t hstepA = Epi::PERMA ? (size_t)4 * K * 2 : hstep;
    const size_t tstep = 2 * hstep;
    const unsigned ldsw = (unsigned)wid * 1024u;
    const int aoff = lds_byte(wr * 64 + fr, fq * 8), boff = lds_byte(wc * 32 + fr, fq * 8);
#define PG8_SA(b, h) (((b) * 2 + (h)) * HTB)
#define PG8_SB(b, h) ((4 + (b) * 2 + (h)) * HTB)
#define PG8_STAGE(bufoff, gbase, voff) do { _Pragma("unroll") for (int _i = 0; _i < 2; ++_i) \
        __builtin_amdgcn_global_load_lds((const unsigned*)((const char*)(gbase) + (voff)[_i]), (LAS unsigned*)(lds + (bufoff) + ldsw + _i * 8192), 16, 0, 0); } while (0)
#define PG8_LDA(dst, b, h) do { _Pragma("unroll") for (int m = 0; m < 4; ++m) _Pragma("unroll") for (int k = 0; k < 2; ++k) dst[m][k] = *(const LAS bf16x8*)(lds + PG8_SA(b, h) + aoff + m * 2048 + k * 1024); } while (0)
#define PG8_LDB(dst, b, h) do { _Pragma("unroll") for (int n = 0; n < 2; ++n) _Pragma("unroll") for (int k = 0; k < 2; ++k) dst[n][k] = *(const LAS bf16x8*)(lds + PG8_SB(b, h) + boff + n * 2048 + k * 1024); } while (0)
#define PG8_MMA(ai, bj, At, Bt) do { __builtin_amdgcn_s_setprio(1); _Pragma("unroll") for (int m = 0; m < 4; ++m) _Pragma("unroll") for (int n = 0; n < 2; ++n) _Pragma("unroll") for (int k = 0; k < 2; ++k) \
        acc[ai][bj][m][n] = __builtin_amdgcn_mfma_f32_16x16x32_bf16(Bt[n][k], At[m][k], acc[ai][bj][m][n], 0, 0, 0); __builtin_amdgcn_s_setprio(0); } while (0)
#define PG8_WAIT_V(n) asm volatile("s_waitcnt vmcnt(" #n ")" ::: "memory")
#define PG8_WAIT_L(n) asm volatile("s_waitcnt lgkmcnt(" #n ")" ::: "memory")
#define PG8_BAR __builtin_amdgcn_s_barrier()
#define PG8_SCHED __builtin_amdgcn_sched_barrier(0)
    Unit cur, nxt; int ui = 0;
    if (!S.next(0, cur)) return;
    E.pin();
    asm volatile("s_waitcnt lgkmcnt(0)" ::: "memory");
    f32x4 acc[2][2][4][2];
#pragma unroll
    for (int a = 0; a < 2; ++a)
#pragma unroll
        for (int b = 0; b < 2; ++b)
#pragma unroll
            for (int m = 0; m < 4; ++m)
#pragma unroll
                for (int n = 0; n < 2; ++n) acc[a][b][m][n] = (f32x4){0.f, 0.f, 0.f, 0.f};
    bf16x8 At[4][2], B0[2][2], B1[2][2];
    const char* cA = (const char*)g.A + (size_t)cur.pm * tstep; const char* cB = (const char*)g.Bt + (size_t)cur.pn * tstep;
    PG8_STAGE(PG8_SB(0, 0), cB, voffB); PG8_STAGE(PG8_SA(0, 0), cA, voffA); PG8_STAGE(PG8_SB(0, 1), cB + hstep, voffB); PG8_STAGE(PG8_SA(0, 1), cA + hstepA, voffA);
    if (wr == 1) PG8_BAR;
    PG8_WAIT_V(4); PG8_BAR;
    PG8_STAGE(PG8_SB(1, 0), cB + kstep, voffB); PG8_STAGE(PG8_SA(1, 0), cA + kstep, voffA); PG8_STAGE(PG8_SB(1, 1), cB + hstep + kstep, voffB);
    PG8_WAIT_V(6); PG8_BAR;
    for (;;) {
        const bool has_next = S.next(ui + 1, nxt);
        const char* nA = has_next ? (const char*)g.A + (size_t)nxt.pm * tstep : cA; const char* nB = has_next ? (const char*)g.Bt + (size_t)nxt.pn * tstep : cB;
        for (int t = 0; t < nt; t += 2) {
            const bool last = (t == nt - 2);
            const char* a1 = cA + (size_t)(t + 1) * kstep;
            const char* a2 = last ? nA : cA + (size_t)(t + 2) * kstep; const char* b2 = last ? nB : cB + (size_t)(t + 2) * kstep;
            const char* a3 = a2 + kstep; const char* b3 = b2 + kstep;
            if constexpr (Epi::MID) { if (t == 8 || t == 12) E.mid(acc, cur, t, wr, wc, fr, fq); }
            PG8_LDB(B0, 0, 0); PG8_SCHED; PG8_LDA(At, 0, 0); PG8_STAGE(PG8_SA(1, 1), a1 + hstepA, voffA);
            PG8_WAIT_L(8); PG8_BAR; PG8_WAIT_L(0); PG8_MMA(0, 0, At, B0); PG8_BAR; PG8_SCHED;
            PG8_LDB(B1, 0, 1); PG8_STAGE(PG8_SB(0, 0), b2, voffB);
            PG8_BAR; PG8_WAIT_L(0); PG8_MMA(0, 1, At, B1); PG8_BAR;
            PG8_LDA(At, 0, 1); PG8_STAGE(PG8_SA(0, 0), a2, voffA);
            PG8_BAR; PG8_WAIT_L(0); PG8_MMA(1, 0, At, B0); PG8_BAR; PG8_SCHED;
            PG8_STAGE(PG8_SB(0, 1), b2 + hstep, voffB);
            PG8_WAIT_V(6); PG8_BAR; PG8_MMA(1, 1, At, B1); PG8_BAR;
            PG8_LDB(B0, 1, 0); PG8_SCHED; PG8_LDA(At, 1, 0); PG8_STAGE(PG8_SA(0, 1), a2 + hstepA, voffA);
            PG8_WAIT_L(8); PG8_BAR; PG8_WAIT_L(0); PG8_MMA(0, 0, At, B0); PG8_BAR; PG8_SCHED;
            PG8_LDB(B1, 1, 1); PG8_STAGE(PG8_SB(1, 0), b3, voffB);
            PG8_BAR; PG8_WAIT_L(0); PG8_MMA(0, 1, At, B1); PG8_BAR;
            PG8_LDA(At, 1, 1); PG8_STAGE(PG8_SA(1, 0), a3, voffA);
            PG8_BAR; PG8_WAIT_L(0); PG8_MMA(1, 0, At, B0); PG8_BAR; PG8_SCHED;
            PG8_STAGE(PG8_SB(1, 1), b3 + hstep, voffB);
            PG8_WAIT_V(6); PG8_BAR; PG8_MMA(1, 1, At, B1); PG8_BAR;
        }
        if constexpr (!Epi::DRAIN) E(acc, cur, wr, wc, fr, fq);
        if (!has_next) break;
#pragma unroll
        for (int a = 0; a < 2; ++a)
#pragma unroll
            for (int b = 0; b < 2; ++b)
#pragma unroll
                for (int m = 0; m < 4; ++m)
#pragma unroll
                    for (int n = 0; n < 2; ++n) acc[a][b][m][n] = (f32x4){0.f, 0.f, 0.f, 0.f};
        cur = nxt; cA = nA; cB = nB; ++ui;
    }
    PG8_WAIT_V(0);
    if (wr == 0) PG8_BAR;
    PG8_BAR;
    if constexpr (Epi::DRAIN) E(acc, cur, wr, wc, fr, fq);
#undef PG8_SA
#undef PG8_SB
#undef PG8_STAGE
#undef PG8_LDA
#undef PG8_LDB
#undef PG8_MMA
#undef PG8_WAIT_V
#undef PG8_WAIT_L
#undef PG8_BAR
#undef PG8_SCHED
}

typedef f32x4 Acc[2][2][4][2];

struct EpiG1 {
    static constexpr bool PERM = true, PERMA = false, MID = false, DRAIN = false;
    bf16_t* UV; float* BP; bf16_t* Q; bf16_t* GATES; const float* bgate;
    __device__ __forceinline__ void pin() const { asm volatile("" :: "s"(UV), "s"(BP), "s"(Q), "s"(GATES), "s"(bgate)); }
    __device__ __forceinline__ void operator()(const Acc& acc, const Unit& u, int wr, int wc, int fr, int fq) const {
        const int row0 = u.pm * BM + wr * 64 + fr, colw = wc * 32 + 8 * fq;
        if (u.pn < 4) {
#pragma unroll
            for (int ai = 0; ai < 2; ++ai)
#pragma unroll
                for (int m = 0; m < 4; ++m) { bf16_t* rowp = UV + (size_t)(row0 + ai * HALF + m * 16) * 1024 + u.pn * 256 + colw;
#pragma unroll
                    for (int bj = 0; bj < 2; ++bj) *(u32x4*)(rowp + bj * HALF) = pack8(gelu4(acc[ai][bj][m][0]), gelu4(acc[ai][bj][m][1])); }
        } else if (u.pn == 4) {
#pragma unroll
            for (int ai = 0; ai < 2; ++ai)
#pragma unroll
                for (int m = 0; m < 4; ++m) { float* rowp = BP + (size_t)(row0 + ai * HALF + m * 16) * 256 + colw;
#pragma unroll
                    for (int bj = 0; bj < 2; ++bj) { *(f32x4*)(rowp + bj * HALF) = acc[ai][bj][m][0]; *(f32x4*)(rowp + bj * HALF + 4) = acc[ai][bj][m][1]; } }
        } else if (u.pn == 5) {
#pragma unroll
            for (int ai = 0; ai < 2; ++ai)
#pragma unroll
                for (int m = 0; m < 4; ++m) { bf16_t* rowp = Q + (size_t)(row0 + ai * HALF + m * 16) * 256 + colw;
#pragma unroll
                    for (int bj = 0; bj < 2; ++bj) *(u32x4*)(rowp + bj * HALF) = pack8(acc[ai][bj][m][0] * 0.125f, acc[ai][bj][m][1] * 0.125f); }
        } else {
            const int gc0 = (u.pn - 6) * 256 + colw;
            f32x4 bv[2][2];
#pragma unroll
            for (int bj = 0; bj < 2; ++bj)
#pragma unroll
                for (int n = 0; n < 2; ++n) bv[bj][n] = *(const f32x4*)(bgate + gc0 + bj * HALF + 4 * n);
#pragma unroll
            for (int ai = 0; ai < 2; ++ai)
#pragma unroll
                for (int m = 0; m < 4; ++m) { bf16_t* rowp = GATES + (size_t)(row0 + ai * HALF + m * 16) * 3072 + gc0;
#pragma unroll
                    for (int bj = 0; bj < 2; ++bj) { f32x4 v0 = acc[ai][bj][m][0] + bv[bj][0], v1 = acc[ai][bj][m][1] + bv[bj][1];
#pragma unroll
                        for (int j = 0; j < 4; ++j) { v0[j] = sigm1(v0[j]); v1[j] = sigm1(v1[j]); }
                        *(u32x4*)(rowp + bj * HALF) = pack8(v0, v1); } }
        }
    }
};

struct EpiKV {
    static constexpr bool PERM = false, PERMA = false, MID = false, DRAIN = false;
    float* outK; float* outV; bf16_t* KB; bf16_t* VT;
    __device__ __forceinline__ void pin() const { asm volatile("" :: "s"(outK), "s"(outV), "s"(KB), "s"(VT)); }
    __device__ __forceinline__ void operator()(const Acc& acc, const Unit& u, int wr, int wc, int fr, int fq) const {
#pragma unroll
        for (int ai = 0; ai < 2; ++ai)
#pragma unroll
            for (int m = 0; m < 4; ++m) { const int r = u.pm * BM + ai * HALF + wr * 64 + m * 16 + fr;
#pragma unroll
                for (int bj = 0; bj < 2; ++bj)
#pragma unroll
                    for (int n = 0; n < 2; ++n) { const int c = bj * HALF + wc * 32 + n * 16 + 4 * fq; const f32x4 v = acc[ai][bj][m][n];
                        if (u.pn == 0) { *(f32x4*)(outK + (size_t)r * 256 + c) = v; *(u32x2*)(KB + (size_t)r * 256 + c) = pack4(v); }
                        else { *(f32x4*)(outV + (size_t)r * 256 + c) = v; const int b = r >> 8, mm = r & 255, h = c >> 6, d = c & 63;
                            bf16_t* vt = VT + ((size_t)((b * 4 + h) * 64 + d)) * 256 + mm;
                            vt[0] = f2bf(v[0]); vt[256] = f2bf(v[1]); vt[512] = f2bf(v[2]); vt[768] = f2bf(v[3]); } } }
    }
};

struct EpiG2 {
    static constexpr bool PERM = true, PERMA = false, MID = true, DRAIN = false;
    const bf16_t* GATES; bf16_t* MERGED;
    __device__ __forceinline__ void pin() const { asm volatile("" :: "s"(GATES), "s"(MERGED)); }
    __device__ __forceinline__ void mid(Acc& acc, const Unit& u, int t, int wr, int wc, int fr, int fq) const {
        int row0 = u.pm * BM + wr * 64 + fr; asm volatile("" : "+v"(row0));
        const int col0 = u.pn * 256 + wc * 32 + 8 * fq;
        const int nb = (t == 8) ? 0 : 1024;
#pragma unroll
        for (int ai = 0; ai < 2; ++ai)
#pragma unroll
            for (int m = 0; m < 4; ++m) { const bf16_t* gp = GATES + (size_t)(row0 + ai * HALF + m * 16) * 3072 + nb + col0;
#pragma unroll
                for (int bj = 0; bj < 2; ++bj) { const u32x4 wn = *(const u32x4*)(gp + bj * HALF), wd = *(const u32x4*)(gp + 1024 + bj * HALF);
                    f32x4 n0, n1, d0, d1; unpack8(wn, n0, n1); unpack8(wd, d0, d1);
#pragma unroll
                    for (int j = 0; j < 4; ++j) { acc[ai][bj][m][0][j] *= n0[j] * __builtin_amdgcn_rcpf(d0[j]); acc[ai][bj][m][1][j] *= n1[j] * __builtin_amdgcn_rcpf(d1[j]); } }
                asm volatile("" ::: "memory"); }
    }
    __device__ __forceinline__ void operator()(const Acc& acc, const Unit& u, int wr, int wc, int fr, int fq) const {
        const int row0 = u.pm * BM + wr * 64 + fr, col0 = u.pn * 256 + wc * 32 + 8 * fq;
#pragma unroll
        for (int ai = 0; ai < 2; ++ai)
#pragma unroll
            for (int m = 0; m < 4; ++m) { const size_t r = (size_t)(row0 + ai * HALF + m * 16);
#pragma unroll
                for (int bj = 0; bj < 2; ++bj) { const u32x4 wg = *(const u32x4*)(GATES + r * 3072 + 2048 + col0 + bj * HALF); f32x4 g0, g1; unpack8(wg, g0, g1);
                    *(u32x4*)(MERGED + r * 1024 + col0 + bj * HALF) = pack8(acc[ai][bj][m][0] * g0, acc[ai][bj][m][1] * g1); }
                asm volatile("" ::: "memory"); }
    }
};

struct EpiSS {
    static constexpr bool PERM = false, PERMA = false, MID = false, DRAIN = false;
    float* C; float* SS;
    __device__ __forceinline__ void pin() const { asm volatile("" :: "s"(C), "s"(SS)); }
    __device__ __forceinline__ void operator()(const Acc& acc, const Unit& u, int wr, int wc, int fr, int fq) const {
        const int row0 = u.pm * BM + wr * 64 + fr, col0 = u.pn * BM + wc * 32 + 4 * fq;
#pragma unroll
        for (int ai = 0; ai < 2; ++ai)
#pragma unroll
            for (int m = 0; m < 4; ++m) { const size_t r = (size_t)(row0 + ai * HALF + m * 16); float* rowp = C + r * 1024 + col0; float s = 0.f;
#pragma unroll
                for (int bj = 0; bj < 2; ++bj)
#pragma unroll
                    for (int n = 0; n < 2; ++n) { const f32x4 v = acc[ai][bj][m][n]; *(f32x4*)(rowp + bj * HALF + n * 16) = v; s += (v[0] * v[0] + v[1] * v[1]) + (v[2] * v[2] + v[3] * v[3]); }
                s += __shfl_xor(s, 16); s += __shfl_xor(s, 32);
                if (fq == 0) SS[r * 16 + u.pn * 4 + wc] = s; }
    }
};

struct EpiG4 {
    static constexpr bool PERM = true, PERMA = true, MID = false, DRAIN = false;
    bf16_t* Y; float* GRAW; float* URAW; const float* cw; const float* cb; const float* sconv; float* outCP; float* outCS;
    __device__ __forceinline__ void pin() const { asm volatile("" :: "s"(Y), "s"(GRAW), "s"(URAW), "s"(cw), "s"(cb), "s"(sconv), "s"(outCP), "s"(outCS)); }
    __device__ __forceinline__ void operator()(const Acc& acc, const Unit& u, int wr, int wc, int fr, int fq) const {
#pragma unroll
        for (int n = 0; n < 2; ++n) {
            const int ch = u.pn * 128 + wc * 32 + 8 * fq + 4 * n;
            const f32x4 w0 = *(const f32x4*)(cw + ch), w1 = *(const f32x4*)(cw + DFF + ch), w2 = *(const f32x4*)(cw + 2 * DFF + ch), bb = *(const f32x4*)(cb + ch);
            if (u.pm < 64) {
                const int seg = 2 * u.pm + wr; const size_t tok0 = (size_t)seg * 128 + 8 * fr;
                f32x4 p2 = dpp_shr1_4(acc[1][0][2][n]), p1 = dpp_shr1_4(acc[1][0][3][n]);
#pragma unroll
                for (int j8 = 0; j8 < 8; ++j8) { const f32x4 gv = acc[j8 >> 2][0][j8 & 3][n], uv = acc[j8 >> 2][1][j8 & 3][n];
                    const f32x4 c = bb + w0 * p2 + w1 * p1 + w2 * gv;
                    if (!(fr == 0 && j8 < 2)) *(u32x2*)(Y + (tok0 + j8) * DFF + ch) = pack4(gelu4(c) * uv);
                    p2 = p1; p1 = gv; }
                if (fr == 0) {
                    *(f32x4*)(GRAW + (size_t)(seg * 4 + 2) * DFF + ch) = acc[0][0][0][n]; *(f32x4*)(GRAW + (size_t)(seg * 4 + 3) * DFF + ch) = acc[0][0][1][n];
                    *(f32x4*)(URAW + (size_t)(seg * 2 + 0) * DFF + ch) = acc[0][1][0][n]; *(f32x4*)(URAW + (size_t)(seg * 2 + 1) * DFF + ch) = acc[0][1][1][n];
                }
                if (fr == 15) {
                    *(f32x4*)(GRAW + (size_t)(seg * 4 + 0) * DFF + ch) = acc[1][0][2][n]; *(f32x4*)(GRAW + (size_t)(seg * 4 + 1) * DFF + ch) = acc[1][0][3][n];
                    if ((seg & 15) == 15) { const int b = seg >> 4; *(f32x4*)(outCP + (size_t)(b * 2 + 0) * DFF + ch) = acc[1][0][2][n]; *(f32x4*)(outCP + (size_t)(b * 2 + 1) * DFF + ch) = acc[1][0][3][n]; }
                }
            } else {
                const int si0 = 256 * (u.pm - 64) + 128 * wr + 8 * fr;
#pragma unroll
                for (int hh = 0; hh < 2; ++hh) { const int b = (si0 >> 2) + hh;
                    f32x4 p2 = *(const f32x4*)(sconv + (size_t)(b * 2 + 0) * DFF + ch), p1 = *(const f32x4*)(sconv + (size_t)(b * 2 + 1) * DFF + ch);
#pragma unroll
                    for (int t = 0; t < 4; ++t) { const f32x4 gv = acc[hh][0][t][n], uv = acc[hh][1][t][n];
                        const f32x4 c = bb + w0 * p2 + w1 * p1 + w2 * gv;
                        *(u32x2*)(Y + (size_t)(NPROMPT + b * 4 + t) * DFF + ch) = pack4(gelu4(c) * uv);
                        p2 = p1; p1 = gv; }
                    *(f32x4*)(outCS + (size_t)(b * 2 + 0) * DFF + ch) = acc[hh][0][2][n]; *(f32x4*)(outCS + (size_t)(b * 2 + 1) * DFF + ch) = acc[hh][0][3][n]; }
            }
        }
    }
};

__device__ __forceinline__ void prep_tile(const float* src, int ldsrc, int k0, int n0, bf16_t* dst, int lddst, int dstrow0, int dstk0, LAS float* T) {
    const int tid = ltid();
#pragma unroll
    for (int i = 0; i < 2; ++i) { const int idx = tid + 512 * i, kk = idx >> 4, c4 = (idx & 15) * 4;
        const f32x4 v = *(const f32x4*)(src + (size_t)(k0 + kk) * ldsrc + n0 + c4);
        T[kk * 65 + c4] = v[0]; T[kk * 65 + c4 + 1] = v[1]; T[kk * 65 + c4 + 2] = v[2]; T[kk * 65 + c4 + 3] = v[3]; }
    __syncthreads();
    { const int nn = tid >> 3, kc = (tid & 7) * 8; f32x4 a, b;
#pragma unroll
      for (int i = 0; i < 4; ++i) { a[i] = T[(kc + i) * 65 + nn]; b[i] = T[(kc + 4 + i) * 65 + nn]; }
      *(u32x4*)(dst + (size_t)(dstrow0 + nn) * lddst + dstk0 + kc) = pack8(a, b); }
    __syncthreads();
}
__device__ __forceinline__ void prep_wpb(const float* wp, const float* ps, const float* wb, int g, int n0, bf16_t* WbrT, LAS float* T) {
    const int tid = ltid(); LAS float* TA = T; LAS float* TB = T + 64 * 65;
#pragma unroll
    for (int i = 0; i < 2; ++i) { const int idx = tid + 512 * i, kk = idx >> 4, c4 = (idx & 15) * 4;
        const f32x4 va = *(const f32x4*)(wp + (size_t)(g * 64 + kk) * 64 + c4), sc = *(const f32x4*)(ps + g * 64 + c4);
        const f32x4 vb = *(const f32x4*)(wb + (size_t)(g * 64 + kk) * 1024 + n0 + c4);
#pragma unroll
        for (int j = 0; j < 4; ++j) { TA[kk * 65 + c4 + j] = va[j] * sc[j]; TB[kk * 65 + c4 + j] = vb[j]; } }
    __syncthreads();
    { const int nn = tid >> 3, dc = (tid & 7) * 8; f32x4 a = {0.f, 0.f, 0.f, 0.f}, b = {0.f, 0.f, 0.f, 0.f};
      for (int e = 0; e < 64; ++e) { const float bv = TB[e * 65 + nn];
#pragma unroll
          for (int i = 0; i < 4; ++i) { a[i] += TA[(dc + i) * 65 + e] * bv; b[i] += TA[(dc + 4 + i) * 65 + e] * bv; } }
      *(u32x4*)(WbrT + (size_t)(n0 + nn) * 1024 + 512 + g * 64 + dc) = pack8(a, b); }
    __syncthreads();
}
__device__ __forceinline__ void rms_row_to_bf16(const float* xrow, const float* gain, bf16_t* dst, int lane) {
    f32x4 v[4]; float s = 0.f;
#pragma unroll
    for (int i = 0; i < 2; ++i) { v[2 * i] = *(const f32x4*)(xrow + lane * 8 + 512 * i); v[2 * i + 1] = *(const f32x4*)(xrow + lane * 8 + 512 * i + 4); }
#pragma unroll
    for (int i = 0; i < 4; ++i) s += (v[i][0] * v[i][0] + v[i][1] * v[i][1]) + (v[i][2] * v[i][2] + v[i][3] * v[i][3]);
    s = wave_sum(s); const float inv = rsqrtf(s * (1.0f / 1024.0f) + EPSV);
#pragma unroll
    for (int i = 0; i < 2; ++i) { const f32x4 g0 = *(const f32x4*)(gain + lane * 8 + 512 * i), g1 = *(const f32x4*)(gain + lane * 8 + 512 * i + 4);
        *(u32x4*)(dst + lane * 8 + 512 * i) = pack8(v[2 * i] * inv * g0, v[2 * i + 1] * inv * g1); }
}

__device__ __forceinline__ void phase_prep(KP p, LAS unsigned char* lds) {
    unsigned char* ws = p->ws; LAS float* T = (LAS float*)lds;
    bf16_t* WinT = (bf16_t*)(ws + WS_WIN); bf16_t* WkvT = (bf16_t*)(ws + WS_WKV); bf16_t* WbrT = (bf16_t*)(ws + WS_WBR); bf16_t* WoutT = (bf16_t*)(ws + WS_WOUT);
    bf16_t* WupT = (bf16_t*)(ws + WS_WUP); bf16_t* WdownT = (bf16_t*)(ws + WS_WDOWN); bf16_t* WsT = (bf16_t*)(ws + WS_WST);
    const int G = gridDim.x, tid = ltid(), lane = tid & 63, wid = tid >> 6;
    for (int row = blockIdx.x * 8 + wid; row < MT + 2048; row += G * 8) {
        if (row < MT) { const float* xr = row < NPROMPT ? p->in[0] + (size_t)row * 1024 : p->in[1] + (size_t)(row - NPROMPT) * 1024;
            rms_row_to_bf16(xr, p->in[7], (bf16_t*)(ws + WS_R1) + (size_t)row * 1024, lane); }
        else { const int r = row - MT; rms_row_to_bf16(p->in[2] + (size_t)r * 1024, p->in[19], (bf16_t*)(ws + WS_MEMN) + (size_t)r * 1024, lane); }
    }
    for (int i = blockIdx.x * 512 + tid; i < 4 * 128 * 128; i += G * 512) { const int t = (i >> 7) & 127, s = i & 127; WsT[i] = (s <= t) ? f2bf(p->in[15][i]) : (bf16_t)0; }
    constexpr int J0 = 16 * 72, J1 = J0 + 16 * 8, J2 = J1 + 16 * 16, J3 = J2 + 16 * 88, J4 = J3 + 44 * 16, J5 = J4 + 8 * 16, J6 = J5 + 4 * 16, J7 = J6 + 4 * 16;
    for (int job = blockIdx.x; job < J7; job += G) {
        if (job < J0) { const int kt = job / 72, nt = job % 72; prep_tile(p->in[11], DIN, kt * 64, nt * 64, WinT, 1024, nt * 64, kt * 64, T); }
        else if (job < J1) { const int j = job - J0, kt = j / 8, nt = j % 8; prep_tile(p->in[20], 512, kt * 64, nt * 64, WkvT, 1024, nt * 64, kt * 64, T); }
        else if (job < J2) { const int j = job - J1, kt = j / 16, nt = j % 16; prep_tile(p->in[24], 1024, kt * 64, nt * 64, WoutT, 1024, nt * 64, kt * 64, T); }
        else if (job < J3) { const int j = job - J2, kt = j / 88, nt = j % 88; const int n0 = nt * 64; const int cc = n0 < DFF ? n0 : n0 - DFF;
            const int drow = (cc >> 7) * 256 + (n0 < DFF ? 0 : 128) + (cc & 127); prep_tile(p->in[25], NUP, kt * 64, n0, WupT, 1024, drow, kt * 64, T); }
        else if (job < J4) { const int j = job - J3, kt = j / 16, nt = j % 16; prep_tile(p->in[28], 1024, kt * 64, nt * 64, WdownT, DFF, nt * 64, kt * 64, T); }
        else if (job < J5) { const int j = job - J4, kt = j / 16, nt = j % 16; prep_tile(p->in[21], 1024, kt * 64, nt * 64, WbrT, 1024, nt * 64, kt * 64, T); }
        else if (job < J6) { const int j = job - J5, kt = j / 16, nt = j % 16; prep_tile(p->in[23], 1024, kt * 64, nt * 64, WbrT, 1024, nt * 64, 768 + kt * 64, T); }
        else { const int j = job - J6, g = j / 16, nt = j % 16; prep_wpb(p->in[17], p->in[18], p->in[22], g, nt * 64, WbrT, T); }
    }
}

__device__ __forceinline__ void mixA_prompt(KP p, int item, LAS unsigned char* lds) {
    const int tid = ltid(), lane = tid & 63, wid = tid >> 6, fr = lane & 15, fq = lane >> 4;
    const int g = item & 3, tok0 = (item >> 2) * 128;
    const bf16_t* UV = (const bf16_t*)(p->ws + WS_R2); bf16_t* ABC = (bf16_t*)(p->ws + WS_R1); const bf16_t* WsT = (const bf16_t*)(p->ws + WS_WST);
    LAS bf16_t* vnT = (LAS bf16_t*)lds;
    { const int row = tid >> 2, part = tid & 3; const bf16_t* vrow = UV + (size_t)(tok0 + row) * 1024 + 512;
      float s = 0.f, q = 0.f;
#pragma unroll 4
      for (int i = 0; i < 16; ++i) { const u32x4 w = *(const u32x4*)(vrow + part * 128 + i * 8); f32x4 a, b; unpack8(w, a, b);
          s += (a[0] + a[1]) + (a[2] + a[3]) + (b[0] + b[1]) + (b[2] + b[3]);
          q += (a[0] * a[0] + a[1] * a[1]) + (a[2] * a[2] + a[3] * a[3]) + (b[0] * b[0] + b[1] * b[1]) + (b[2] * b[2] + b[3] * b[3]); }
      s += __shfl_xor(s, 1); s += __shfl_xor(s, 2); q += __shfl_xor(q, 1); q += __shfl_xor(q, 2);
      const float mean = s * (1.0f / 512.0f), var = fmaxf(q * (1.0f / 512.0f) - mean * mean, 0.f), rstd = rsqrtf(var + EPSV);
#pragma unroll
      for (int i = 0; i < 4; ++i) { const int d0 = part * 32 + i * 8; const u32x4 w = *(const u32x4*)(vrow + g * 128 + d0); f32x4 a, b; unpack8(w, a, b);
          const f32x4 g0 = *(const f32x4*)(p->in[13] + g * 128 + d0), g1 = *(const f32x4*)(p->in[13] + g * 128 + d0 + 4);
          const f32x4 b0 = *(const f32x4*)(p->in[14] + g * 128 + d0), b1 = *(const f32x4*)(p->in[14] + g * 128 + d0 + 4);
          a = (a - mean) * rstd * g0 + b0; b = (b - mean) * rstd * g1 + b1;
#pragma unroll
          for (int j = 0; j < 4; ++j) { vnT[(d0 + j) * 136 + row] = f2bf(a[j]); vnT[(d0 + 4 + j) * 136 + row] = f2bf(b[j]); } } }
    __syncthreads();
    { f32x4 acc[8];
#pragma unroll
      for (int nb = 0; nb < 8; ++nb) acc[nb] = (f32x4){0.f, 0.f, 0.f, 0.f};
      const int nks = (wid >> 1) + 1;
      for (int ks = 0; ks < nks; ++ks) {
          const bf16x8 wf = *(const bf16x8*)(WsT + (size_t)g * 16384 + (16 * wid + fr) * 128 + ks * 32 + fq * 8);
#pragma unroll
          for (int nb = 0; nb < 8; ++nb) { const bf16x8 vf = *(const LAS bf16x8*)(vnT + (nb * 16 + fr) * 136 + ks * 32 + fq * 8);
              acc[nb] = __builtin_amdgcn_mfma_f32_16x16x32_bf16(vf, wf, acc[nb], 0, 0, 0); } }
      const int t = 16 * wid + fr; const size_t tok = (size_t)tok0 + t; const float bias = p->in[16][g * 128 + t];
#pragma unroll
      for (int nb = 0; nb < 8; ++nb) { const int ch = g * 128 + nb * 16 + fq * 4; const f32x4 uu = unpack4(*(const u32x2*)(UV + tok * 1024 + ch));
          *(u32x2*)(ABC + tok * 1024 + ch) = pack4(uu * (acc[nb] + bias)); } }
    __syncthreads();
}

__device__ __forceinline__ void mixC_prompt(KP p, int item) {
    const int tid = ltid(), lane = tid & 63, wid = tid >> 6, fr = lane & 15, fq = lane >> 4;
    const int h = item & 3, bc = item >> 2, b = bc >> 4, tok0 = bc * 128;
    const bf16_t* Q = (const bf16_t*)(p->ws + WS_Q); const bf16_t* KB = (const bf16_t*)(p->ws + WS_KB); const bf16_t* VT = (const bf16_t*)(p->ws + WS_VT); bf16_t* ABC = (bf16_t*)(p->ws + WS_R1);
    const size_t qrow = (size_t)tok0 + 16 * wid + fr;
    const bf16x8 q0 = *(const bf16x8*)(Q + qrow * 256 + h * 64 + fq * 8), q1 = *(const bf16x8*)(Q + qrow * 256 + h * 64 + 32 + fq * 8);
    f32x4 s[16];
#pragma unroll
    for (int kb = 0; kb < 16; ++kb) { const bf16_t* kp = KB + (size_t)(b * 256 + kb * 16 + fr) * 256 + h * 64 + fq * 8;
        const bf16x8 k0 = *(const bf16x8*)kp, k1 = *(const bf16x8*)(kp + 32);
        s[kb] = __builtin_amdgcn_mfma_f32_16x16x32_bf16(k0, q0, (f32x4){0.f, 0.f, 0.f, 0.f}, 0, 0, 0);
        s[kb] = __builtin_amdgcn_mfma_f32_16x16x32_bf16(k1, q1, s[kb], 0, 0, 0); }
    float mx = -3.0e38f;
#pragma unroll
    for (int kb = 0; kb < 16; ++kb) mx = fmaxf(mx, fmaxf(fmaxf(s[kb][0], s[kb][1]), fmaxf(s[kb][2], s[kb][3])));
    mx = fmaxf(mx, __shfl_xor(mx, 16)); mx = fmaxf(mx, __shfl_xor(mx, 32));
    float sum = 0.f;
#pragma unroll
    for (int kb = 0; kb < 16; ++kb) {
#pragma unroll
        for (int j = 0; j < 4; ++j) { const float e = __builtin_amdgcn_exp2f((s[kb][j] - mx) * 1.442695041f); s[kb][j] = e; sum += e; } }
    sum += __shfl_xor(sum, 16); sum += __shfl_xor(sum, 32);
    f32x4 o[4];
#pragma unroll
    for (int db = 0; db < 4; ++db) o[db] = (f32x4){0.f, 0.f, 0.f, 0.f};
#pragma unroll
    for (int kk = 0; kk < 8; ++kk) { const u32x4 pw = pack8(s[2 * kk], s[2 * kk + 1]); const bf16x8 pf = __builtin_bit_cast(bf16x8, pw);
#pragma unroll
        for (int db = 0; db < 4; ++db) { const bf16_t* vp = VT + ((size_t)((b * 4 + h) * 64 + db * 16 + fr)) * 256 + kk * 32 + fq * 4;
            const u32x2 v0 = *(const u32x2*)vp, v1 = *(const u32x2*)(vp + 16); u32x4 vw; vw[0] = v0[0]; vw[1] = v0[1]; vw[2] = v1[0]; vw[3] = v1[1];
            o[db] = __builtin_amdgcn_mfma_f32_16x16x32_bf16(__builtin_bit_cast(bf16x8, vw), pf, o[db], 0, 0, 0); } }
    const float inv = 1.0f / sum;
#pragma unroll
    for (int db = 0; db < 4; ++db) *(u32x2*)(ABC + qrow * 1024 + 768 + h * 64 + db * 16 + fq * 4) = pack4(o[db] * inv);
}

template <int W> __device__ __forceinline__ void poolB_seg(const float* __restrict__ BP, bf16_t* __restrict__ ABC, float* __restrict__ outP, int b, int p0, int ch) {
    const size_t tb = (size_t)b * 2048;
    float x[32];
#pragma unroll
    for (int k = 0; k < 32; ++k) { const int ps = p0 - 16 + k; x[k] = (ps >= 0) ? BP[(tb + ps) * 256 + ch] : 0.f; }
#pragma unroll
    for (int i = 0; i < 16; ++i) { float S = 0.f;
#pragma unroll
        for (int j = 0; j < W; ++j) S += x[16 + i - j];
        const int pos = p0 + i; const int cnt = (pos + 1 < W) ? pos + 1 : W;
        ABC[(tb + pos) * 1024 + 512 + ch] = f2bf(S / (float)cnt - x[16 + i]);
        if (pos >= 2033) outP[(size_t)(b * 15 + pos - 2033) * 256 + ch] = x[16 + i]; }
}
__device__ __forceinline__ void mixB_prompt(KP p, int item) {
    const int tid = ltid(), ch = tid & 255, seg = tid >> 8, g = ch >> 6;
    const int q = item & 3, bc = item >> 2, b = bc >> 4, c = bc & 15, p0 = c * 128 + q * 32 + seg * 16;
    const float* BP = (const float*)(p->ws + WS_BP); bf16_t* ABC = (bf16_t*)(p->ws + WS_R1); float* outP = p->out + O_POOLP;
    if (g == 0) poolB_seg<2>(BP, ABC, outP, b, p0, ch); else if (g == 1) poolB_seg<4>(BP, ABC, outP, b, p0, ch);
    else if (g == 2) poolB_seg<8>(BP, ABC, outP, b, p0, ch); else poolB_seg<16>(BP, ABC, outP, b, p0, ch);
}

template <int W> __device__ __forceinline__ void poolS(const float* __restrict__ sp, const float* __restrict__ BP, bf16_t* __restrict__ ABC, float* __restrict__ outS, size_t tokS, int ch) {
    float e[19];
#pragma unroll
    for (int k = 0; k < 15; ++k) e[k] = sp[k * 256 + ch];
#pragma unroll
    for (int k = 0; k < 4; ++k) e[15 + k] = BP[(tokS + k) * 256 + ch];
#pragma unroll
    for (int t = 0; t < 4; ++t) { float S = 0.f;
#pragma unroll
        for (int j = 0; j < W; ++j) S += e[15 + t - j];
        ABC[(tokS + t) * 1024 + 512 + ch] = f2bf(S / (float)W - e[15 + t]); }
#pragma unroll
    for (int j = 0; j < 15; ++j) outS[j * 256 + ch] = e[4 + j];
}
__device__ __forceinline__ void mix_sampleAB(KP p, int b, LAS unsigned char* lds) {
    const int tid = ltid(), lane = tid & 63, wid = tid >> 6;
    const bf16_t* UV = (const bf16_t*)(p->ws + WS_R2); bf16_t* ABC = (bf16_t*)(p->ws + WS_R1); const float* BP = (const float*)(p->ws + WS_BP);
    LAS float* red = (LAS float*)lds;
    const size_t tokS = (size_t)NPROMPT + b * 4;
    { const int ch = tid; float v0 = bf2f(UV[(tokS + 0) * 1024 + 512 + ch]), v1 = bf2f(UV[(tokS + 1) * 1024 + 512 + ch]), v2 = bf2f(UV[(tokS + 2) * 1024 + 512 + ch]), v3 = bf2f(UV[(tokS + 3) * 1024 + 512 + ch]);
      const float u0 = bf2f(UV[(tokS + 0) * 1024 + ch]), u1 = bf2f(UV[(tokS + 1) * 1024 + ch]), u2 = bf2f(UV[(tokS + 2) * 1024 + ch]), u3 = bf2f(UV[(tokS + 3) * 1024 + ch]);
      float r0 = wave_sum(v0), r1 = wave_sum(v1), r2 = wave_sum(v2), r3 = wave_sum(v3), r4 = wave_sum(v0 * v0), r5 = wave_sum(v1 * v1), r6 = wave_sum(v2 * v2), r7 = wave_sum(v3 * v3);
      if (lane == 0) { red[wid * 8 + 0] = r0; red[wid * 8 + 1] = r1; red[wid * 8 + 2] = r2; red[wid * 8 + 3] = r3; red[wid * 8 + 4] = r4; red[wid * 8 + 5] = r5; red[wid * 8 + 6] = r6; red[wid * 8 + 7] = r7; }
      __syncthreads();
      float sm[8];
#pragma unroll
      for (int k = 0; k < 8; ++k) { float a = 0.f;
#pragma unroll
          for (int w8 = 0; w8 < 8; ++w8) a += red[w8 * 8 + k]; sm[k] = a; }
      const float lg = p->in[13][ch], lb = p->in[14][ch];
      float vn[4]; const float vv[4] = {v0, v1, v2, v3}; const float uu[4] = {u0, u1, u2, u3};
#pragma unroll
      for (int t = 0; t < 4; ++t) { const float mean = sm[t] * (1.0f / 512.0f), var = fmaxf(sm[4 + t] * (1.0f / 512.0f) - mean * mean, 0.f);
          vn[t] = (vv[t] - mean) * rsqrtf(var + EPSV) * lg + lb; p->out[O_VS + (size_t)(b * 4 + t) * 512 + ch] = vn[t]; }
      const int g = ch >> 7; const float* wsp = p->in[15] + (size_t)g * 16384; const float* bsp = p->in[16] + g * 128;
#pragma unroll
      for (int t = 0; t < 4; ++t) { float sg = bsp[t];
#pragma unroll
          for (int s2 = 0; s2 <= t; ++s2) sg += wsp[t * 128 + s2] * vn[s2];
          ABC[(tokS + t) * 1024 + ch] = f2bf(uu[t] * sg); } }
    if (tid < 256) { const int ch = tid, g = ch >> 6; const float* sp = p->in[5] + (size_t)b * 15 * 256; float* outS = p->out + O_POOLS + (size_t)b * 15 * 256;
        if (g == 0) poolS<2>(sp, BP, ABC, outS, tokS, ch); else if (g == 1) poolS<4>(sp, BP, ABC, outS, tokS, ch);
        else if (g == 2) poolS<8>(sp, BP, ABC, outS, tokS, ch); else poolS<16>(sp, BP, ABC, outS, tokS, ch); }
    __syncthreads();
}

__device__ __forceinline__ void mix_sampleC(KP p, int item, LAS unsigned char* lds) {
    const int tid = ltid(), lane = tid & 63, wid = tid >> 6;
    const int b = item >> 2, h = item & 3; const size_t tokS = (size_t)NPROMPT + b * 4;
    const bf16_t* Q = (const bf16_t*)(p->ws + WS_Q); bf16_t* ABC = (bf16_t*)(p->ws + WS_R1);
    const float* __restrict__ ck = p->in[3] + (size_t)b * 65536 + h * 64; const float* __restrict__ cv = p->in[4] + (size_t)b * 65536 + h * 64;
    LAS float* qs = (LAS float*)lds;
    LAS float* part = (LAS float*)(lds + 1024);
    LAS float* red = (LAS float*)(lds + 1024 + 8192);
    LAS float* P = (LAS float*)(lds + 16384);
    LAS float* po = (LAS float*)(lds + 16384 + 4096);
    if (tid < 256) qs[tid] = bf2f(Q[(tokS + (tid >> 6)) * 256 + h * 64 + (tid & 63)]);
    const int m = tid & 255, half = tid >> 8;
    f32x4 kv[8];
#pragma unroll
    for (int i = 0; i < 8; ++i) kv[i] = *(const f32x4*)(ck + (size_t)m * 256 + half * 32 + i * 4);
    float vv[32];
#pragma unroll
    for (int i = 0; i < 32; ++i) vv[i] = cv[(size_t)(wid * 32 + i) * 256 + lane];
    __syncthreads();
    { float a0 = 0.f, a1 = 0.f, a2 = 0.f, a3 = 0.f;
#pragma unroll
      for (int i = 0; i < 8; ++i) { const int d = half * 32 + i * 4;
          const f32x4 q0 = *(const LAS f32x4*)(qs + d), q1 = *(const LAS f32x4*)(qs + 64 + d), q2 = *(const LAS f32x4*)(qs + 128 + d), q3 = *(const LAS f32x4*)(qs + 192 + d);
          a0 += kv[i][0] * q0[0] + kv[i][1] * q0[1] + kv[i][2] * q0[2] + kv[i][3] * q0[3]; a1 += kv[i][0] * q1[0] + kv[i][1] * q1[1] + kv[i][2] * q1[2] + kv[i][3] * q1[3];
          a2 += kv[i][0] * q2[0] + kv[i][1] * q2[1] + kv[i][2] * q2[2] + kv[i][3] * q2[3]; a3 += kv[i][0] * q3[0] + kv[i][1] * q3[1] + kv[i][2] * q3[2] + kv[i][3] * q3[3]; }
      part[(half * 4 + 0) * 256 + m] = a0; part[(half * 4 + 1) * 256 + m] = a1; part[(half * 4 + 2) * 256 + m] = a2; part[(half * 4 + 3) * 256 + m] = a3; }
    __syncthreads();
    const int t0 = 2 * half;
    float s0 = part[(0 * 4 + t0) * 256 + m] + part[(1 * 4 + t0) * 256 + m], s1 = part[(0 * 4 + t0 + 1) * 256 + m] + part[(1 * 4 + t0 + 1) * 256 + m];
    { const float m0 = wave_max(s0), m1 = wave_max(s1); if (lane == 0) { red[wid * 4 + 0] = m0; red[wid * 4 + 1] = m1; } }
    __syncthreads();
    { const int w0 = half * 4; const float m0 = fmaxf(fmaxf(red[(w0 + 0) * 4 + 0], red[(w0 + 1) * 4 + 0]), fmaxf(red[(w0 + 2) * 4 + 0], red[(w0 + 3) * 4 + 0]));
      const float m1 = fmaxf(fmaxf(red[(w0 + 0) * 4 + 1], red[(w0 + 1) * 4 + 1]), fmaxf(red[(w0 + 2) * 4 + 1], red[(w0 + 3) * 4 + 1]));
      s0 = __builtin_amdgcn_exp2f((s0 - m0) * 1.442695041f); s1 = __builtin_amdgcn_exp2f((s1 - m1) * 1.442695041f);
      const float e0 = wave_sum(s0), e1 = wave_sum(s1); if (lane == 0) { red[wid * 4 + 2] = e0; red[wid * 4 + 3] = e1; } }
    __syncthreads();
    { const int w0 = half * 4; const float e0 = (red[(w0 + 0) * 4 + 2] + red[(w0 + 1) * 4 + 2]) + (red[(w0 + 2) * 4 + 2] + red[(w0 + 3) * 4 + 2]);
      const float e1 = (red[(w0 + 0) * 4 + 3] + red[(w0 + 1) * 4 + 3]) + (red[(w0 + 2) * 4 + 3] + red[(w0 + 3) * 4 + 3]);
      P[t0 * 256 + m] = s0 / e0; P[(t0 + 1) * 256 + m] = s1 / e1; }
    __syncthreads();
    { float o0 = 0.f, o1 = 0.f, o2 = 0.f, o3 = 0.f;
#pragma unroll
      for (int i4 = 0; i4 < 8; ++i4) { const int mm = wid * 32 + i4 * 4;
          const f32x4 p0 = *(const LAS f32x4*)(P + mm), p1 = *(const LAS f32x4*)(P + 256 + mm), p2 = *(const LAS f32x4*)(P + 512 + mm), p3 = *(const LAS f32x4*)(P + 768 + mm);
#pragma unroll
          for (int j = 0; j < 4; ++j) { const float v = vv[i4 * 4 + j]; o0 += p0[j] * v; o1 += p1[j] * v; o2 += p2[j] * v; o3 += p3[j] * v; } }
      po[(wid * 4 + 0) * 64 + lane] = o0; po[(wid * 4 + 1) * 64 + lane] = o1; po[(wid * 4 + 2) * 64 + lane] = o2; po[(wid * 4 + 3) * 64 + lane] = o3; }
    __syncthreads();
    if (tid < 256) { const int t = tid >> 6, d = tid & 63; float o = 0.f;
#pragma unroll
        for (int g8 = 0; g8 < 8; ++g8) o += po[(g8 * 4 + t) * 64 + d];
        ABC[(tokS + t) * 1024 + 768 + h * 64 + d] = f2bf(o); }
    __syncthreads();
}

__device__ __forceinline__ void tail_g2(unsigned char* ws, int bx) {
    const int tid = ltid(), lane = tid & 63, wid = tid >> 6, fr = lane & 15, fq = lane >> 4;
    const int row = NPROMPT + 32 * (bx >> 4) + 16 * (wid >> 2) + fr, colb = 64 * (bx & 15) + 16 * (wid & 3);
    const bf16_t* __restrict__ A = (const bf16_t*)(ws + WS_R1) + (size_t)row * 1024 + fq * 8;
    const bf16_t* __restrict__ B = (const bf16_t*)(ws + WS_WBR) + (size_t)(colb + fr) * 1024 + fq * 8;
    const bf16_t* __restrict__ GT = (const bf16_t*)(ws + WS_R3) + (size_t)row * 3072 + colb + fq * 4;
    f32x4 acc = {0.f, 0.f, 0.f, 0.f};
    for (int k0 = 0; k0 < 1024; k0 += 256) {
        if (k0 == 512 || k0 == 768) { const int nb = (k0 == 512) ? 0 : 1024; const f32x4 nu = unpack4(*(const u32x2*)(GT + nb)), de = unpack4(*(const u32x2*)(GT + nb + 1024));
#pragma unroll
            for (int j = 0; j < 4; ++j) acc[j] *= nu[j] * __builtin_amdgcn_rcpf(de[j]); }
        bf16x8 a[8], b[8];
#pragma unroll
        for (int u = 0; u < 8; ++u) { a[u] = *(const bf16x8*)(A + k0 + u * 32); b[u] = *(const bf16x8*)(B + k0 + u * 32); }
#pragma unroll
        for (int u = 0; u < 8; ++u) acc = __builtin_amdgcn_mfma_f32_16x16x32_bf16(b[u], a[u], acc, 0, 0, 0);
    }
    const f32x4 g2 = unpack4(*(const u32x2*)(GT + 2048));
    *(u32x2*)((bf16_t*)(ws + WS_R2) + (size_t)row * 1024 + colb + fq * 4) = pack4(acc * g2);
}
__device__ __forceinline__ void tail_ss(const bf16_t* __restrict__ Abase, const bf16_t* __restrict__ Bbase, int K, float* __restrict__ C, float* __restrict__ SS, LAS unsigned char* lds, int bx) {
    const int tid = ltid(), lane = tid & 63, wid = tid >> 6, fr = lane & 15, fq = lane >> 4;
    const int rl = 16 * (wid >> 2) + fr, row = NPROMPT + 32 * (bx >> 4) + rl, colb = 64 * (bx & 15) + 16 * (wid & 3);
    const bf16_t* __restrict__ A = Abase + (size_t)row * K + fq * 8;
    const bf16_t* __restrict__ B = Bbase + (size_t)(colb + fr) * K + fq * 8;
    f32x4 acc = {0.f, 0.f, 0.f, 0.f};
    for (int k0 = 0; k0 < K; k0 += 256) {
        bf16x8 a[8], b[8];
#pragma unroll
        for (int u = 0; u < 8; ++u) { a[u] = *(const bf16x8*)(A + k0 + u * 32); b[u] = *(const bf16x8*)(B + k0 + u * 32); }
#pragma unroll
        for (int u = 0; u < 8; ++u) acc = __builtin_amdgcn_mfma_f32_16x16x32_bf16(b[u], a[u], acc, 0, 0, 0);
    }
    *(f32x4*)(C + (size_t)row * 1024 + colb + fq * 4) = acc;
    float sq = (acc[0] * acc[0] + acc[1] * acc[1]) + (acc[2] * acc[2] + acc[3] * acc[3]);
    sq += __shfl_xor(sq, 16); sq += __shfl_xor(sq, 32);
    LAS float* red = (LAS float*)lds;
    if (fq == 0) red[rl * 4 + (wid & 3)] = sq;
    __syncthreads();
    if (tid < 32) SS[(size_t)(NPROMPT + 32 * (bx >> 4) + tid) * 16 + (bx & 15)] = (red[tid * 4 + 0] + red[tid * 4 + 1]) + (red[tid * 4 + 2] + red[tid * 4 + 3]);
    __syncthreads();
}

#ifndef PH
#define PH 0x3ff
#endif
#define XB_TMO      128
#define XB_XCNT(j)  (256  + 64 * (j))
#define XB_XSUB(j)  (1280 + 64 * (j))
#define XB_XGEN(j)  (2304 + 64 * (j))
#define XB_TOP      3328
#define XB_TOPGEN   3392
#define XCD_BAR_WORDS 3456
#define XB_SPIN_CAP (1u << 18)

__device__ __forceinline__ unsigned xb_ld(unsigned* p)              { return __hip_atomic_load(p, __ATOMIC_RELAXED, __HIP_MEMORY_SCOPE_AGENT); }
__device__ __forceinline__ unsigned xb_add(unsigned* p, unsigned v) { return __hip_atomic_fetch_add(p, v, __ATOMIC_RELAXED, __HIP_MEMORY_SCOPE_AGENT); }
__device__ __forceinline__ unsigned xb_xcc_id() { return (unsigned)__builtin_amdgcn_s_getreg((3 << 11) | 20) & 0xFu; }
#define XB_SPIN(cond, bar) do { unsigned _sp = 0; while (cond) { __builtin_amdgcn_s_sleep(1); \
    if ((++_sp & 255u) == 0u) { if (xb_ld(&(bar)[XB_TMO])) break; if (_sp > XB_SPIN_CAP) { atomicAdd(&(bar)[XB_TMO], 1u); break; } } } } while (0)

struct XcdBarrier {
    unsigned* bar; unsigned x;
    volatile LAS unsigned* st;
};

__device__ __forceinline__ XcdBarrier xcd_barrier_post(unsigned* bar, volatile LAS unsigned* st) {
    XcdBarrier b; b.bar = bar; b.x = xb_xcc_id(); b.st = st;
    if (threadIdx.x == 0) (void)xb_add(&bar[XB_XCNT(b.x)], 1u);
    return b;
}
__device__ __forceinline__ void xcd_barrier_complete(unsigned* bar, unsigned x, unsigned& nloc, unsigned& nx) {
    const unsigned G = gridDim.x * gridDim.y * gridDim.z;
    unsigned sum, cnt, mine, sp = 0u;
    for (;;) {
        sum = 0u; cnt = 0u; mine = 0u;
#pragma unroll
        for (unsigned j = 0; j < 16; ++j) { const unsigned c = xb_ld(&bar[XB_XCNT(j)]); sum += c; cnt += (c > 0u) ? 1u : 0u; mine = (j == x) ? c : mine; }
        if (sum == G) break;
        __builtin_amdgcn_s_sleep(1);
        if ((++sp & 255u) == 0u) { if (xb_ld(&bar[XB_TMO])) break; if (sp > XB_SPIN_CAP) { atomicAdd(&bar[XB_TMO], 1u); break; } }
    }
    nloc = mine > 0u ? mine : 1u; nx = cnt > 0u ? cnt : 1u;
}

__device__ __forceinline__ void xcd_barrier(const XcdBarrier& b) {
    asm volatile("s_waitcnt vmcnt(0)" ::: "memory");
    __syncthreads();
    if (threadIdx.x == 0) {
        unsigned* bar = b.bar;
        __builtin_amdgcn_s_waitcnt(0);
        unsigned nloc = b.st[0], nx = b.st[1];
        if (nloc == 0u) { xcd_barrier_complete(bar, b.x, nloc, nx); b.st[0] = nloc; b.st[1] = nx; }
        const unsigned old = xb_add(&bar[XB_XSUB(b.x)], 1u);
        const unsigned gen = old / nloc;
        if (old + 1u == (gen + 1u) * nloc) {
            __builtin_amdgcn_fence(__ATOMIC_RELEASE, "agent");
            asm volatile("s_waitcnt vmcnt(0)" ::: "memory");
            const unsigned og = xb_add(&bar[XB_TOP], 1u);
            const unsigned tg = og / nx;
            if (og + 1u == (tg + 1u) * nx) xb_add(&bar[XB_TOPGEN], 1u);
            else XB_SPIN(xb_ld(&bar[XB_TOPGEN]) == tg, bar);
            __builtin_amdgcn_fence(__ATOMIC_ACQUIRE, "agent");
            xb_add(&bar[XB_XGEN(b.x)], 1u);
            asm volatile("s_waitcnt vmcnt(0)" ::: "memory");
        } else {
            XB_SPIN(xb_ld(&bar[XB_XGEN(b.x)]) == gen, bar);
            __builtin_amdgcn_fence(__ATOMIC_ACQUIRE, "agent");
            asm volatile("s_waitcnt vmcnt(0)" ::: "memory");
        }
    }
    __syncthreads();
}
__global__ void __launch_bounds__(512) mega_fwd(Params p_unused) {
    extern __shared__ __attribute__((aligned(16))) unsigned char lds_raw[];
    LAS unsigned char* lds = (LAS unsigned char*)lds_raw;
    const int G = gridDim.x, bx = blockIdx.x;
    { volatile LAS unsigned* st0 = (volatile LAS unsigned*)(lds + 131072 + 4096); if (threadIdx.x < 4) st0[threadIdx.x] = 0u; }
    __syncthreads();
    XcdBarrier xb = xcd_barrier_post((unsigned*)(get_params()->ws + WS_BAR), (volatile LAS unsigned*)(lds + 131072 + 4096));
    cg::this_grid().sync();

#if PH & 1
    { KP p = get_params(); unsigned char* ws = p->ws;
    phase_prep(p, lds);
    }
#endif
    xcd_barrier(xb);

#if PH & 2
    { KP p = get_params(); unsigned char* ws = p->ws;
    { Gemm g{(const bf16_t*)(ws + WS_R1), (const bf16_t*)(ws + WS_WIN), MT, DIN, 1024}; StaticOrder S; S.init(MT, DIN, G, bx);
      EpiG1 E{(bf16_t*)(ws + WS_R2), (float*)(ws + WS_BP), (bf16_t*)(ws + WS_Q), (bf16_t*)(ws + WS_R3), p->in[12]};
      gemm_phase(lds, g, S, E);
      Gemm g2{(const bf16_t*)(ws + WS_MEMN), (const bf16_t*)(ws + WS_WKV), 2048, 512, 1024}; StaticOrder S2; S2.init(2048, 512, G, G - 1 - bx);
      EpiKV E2{p->out + O_MK, p->out + O_MV, (bf16_t*)(ws + WS_KB), (bf16_t*)(ws + WS_VT)};
      gemm_phase(lds, g2, S2, E2); }
    }
#endif
    xcd_barrier(xb);

#if PH & 4
    { KP p = get_params(); unsigned char* ws = p->ws;
    for (int it = bx; it < 512; it += G) mixA_prompt(p, it, lds);
    for (int it = bx; it < 512; it += G) mixC_prompt(p, it);
    for (int it = bx; it < 512; it += G) mixB_prompt(p, it);
    for (int it = G - 1 - bx; it < 512; it += G) mix_sampleC(p, it, lds);
    for (int it = (bx + G / 2) % G; it < 128; it += G) mix_sampleAB(p, it, lds);
    }
#endif
    xcd_barrier(xb);

#if PH & 8
    { KP p = get_params(); unsigned char* ws = p->ws;
    { Gemm g{(const bf16_t*)(ws + WS_R1), (const bf16_t*)(ws + WS_WBR), NPROMPT, 1024, 1024}; StaticOrder S; S.init(NPROMPT, 1024, G, bx);
      EpiG2 E{(const bf16_t*)(ws + WS_R3), (bf16_t*)(ws + WS_R2)};
      gemm_phase(lds, g, S, E);
      for (int blk = bx; blk < 256; blk += G) tail_g2(ws, blk); }
    }
#endif
    xcd_barrier(xb);

#if PH & 16
    { KP p = get_params(); unsigned char* ws = p->ws;
    { Gemm g{(const bf16_t*)(ws + WS_R2), (const bf16_t*)(ws + WS_WOUT), NPROMPT, 1024, 1024}; StaticOrder S; S.init(NPROMPT, 1024, G, bx);
      EpiSS E{(float*)(ws + WS_R3), (float*)(ws + WS_SS1)};
      gemm_phase(lds, g, S, E);
      for (int blk = bx; blk < 256; blk += G) tail_ss((const bf16_t*)(ws + WS_R2), (const bf16_t*)(ws + WS_WOUT), 1024, (float*)(ws + WS_R3), (float*)(ws + WS_SS1), lds, blk); }
    }
#endif
    xcd_barrier(xb);

#if PH & 32
    { KP p = get_params(); unsigned char* ws = p->ws;
    { const int tid = ltid(), lane = tid & 63, wid = tid >> 6; const float* MIX = (const float*)(ws + WS_R3); const float* SS1 = (const float*)(ws + WS_SS1); bf16_t* HN = (bf16_t*)(ws + WS_R1);
      for (int row = bx * 8 + wid; row < MT; row += G * 8) {
          const float* xr = row < NPROMPT ? p->in[0] + (size_t)row * 1024 : p->in[1] + (size_t)(row - NPROMPT) * 1024;
          const f32x4 s0 = *(const f32x4*)(SS1 + (size_t)row * 16), s1 = *(const f32x4*)(SS1 + (size_t)row * 16 + 4), s2 = *(const f32x4*)(SS1 + (size_t)row * 16 + 8), s3 = *(const f32x4*)(SS1 + (size_t)row * 16 + 12);
          const float ss = ((s0[0] + s0[1]) + (s0[2] + s0[3])) + ((s1[0] + s1[1]) + (s1[2] + s1[3])) + ((s2[0] + s2[1]) + (s2[2] + s2[3])) + ((s3[0] + s3[1]) + (s3[2] + s3[3]));
          const float inv = rsqrtf(ss * (1.0f / 1024.0f) + EPSV);
          f32x4 hv[4]; float hs = 0.f;
#pragma unroll
          for (int i = 0; i < 4; ++i) { const int c = lane * 8 + 512 * (i >> 1) + 4 * (i & 1);
              const f32x4 mv = *(const f32x4*)(MIX + (size_t)row * 1024 + c), xv = *(const f32x4*)(xr + c), gp = *(const f32x4*)(p->in[8] + c);
              hv[i] = xv + mv * inv * gp; *(f32x4*)(p->out + O_Y + (size_t)row * 1024 + c) = hv[i];
              hs += (hv[i][0] * hv[i][0] + hv[i][1] * hv[i][1]) + (hv[i][2] * hv[i][2] + hv[i][3] * hv[i][3]); }
          hs = wave_sum(hs); const float inv2 = rsqrtf(hs * (1.0f / 1024.0f) + EPSV);
#pragma unroll
          for (int i = 0; i < 2; ++i) { const int c = lane * 8 + 512 * i; const f32x4 g0 = *(const f32x4*)(p->in[9] + c), g1 = *(const f32x4*)(p->in[9] + c + 4);
              *(u32x4*)(HN + (size_t)row * 1024 + c) = pack8(hv[2 * i] * inv2 * g0, hv[2 * i + 1] * inv2 * g1); } } }
    }
#endif
    xcd_barrier(xb);

#if PH & 64
    { KP p = get_params(); unsigned char* ws = p->ws;
    { Gemm g{(const bf16_t*)(ws + WS_R1), (const bf16_t*)(ws + WS_WUP), MT, NUP, 1024}; StaticOrder S; S.init(MT, NUP, G, bx);
      EpiG4 E{(bf16_t*)(ws + WS_R3), (float*)(ws + WS_GRAW), (float*)(ws + WS_URAW), p->in[26], p->in[27], p->in[6], p->out + O_CONVP, p->out + O_CONVS};
      gemm_phase(lds, g, S, E); }
    }
#endif
    xcd_barrier(xb);

#if PH & 128
    { KP p = get_params(); unsigned char* ws = p->ws;
    { const int tid = ltid(); const float* GRAW = (const float*)(ws + WS_GRAW); const float* URAW = (const float*)(ws + WS_URAW); bf16_t* Y = (bf16_t*)(ws + WS_R3);
      const float* cw = p->in[26]; const float* cb = p->in[27];
      for (int idx = bx * 512 + tid; idx < 128 * 2 * DFF; idx += G * 512) {
          const int seg = idx / (2 * DFF), rem = idx - seg * 2 * DFF, j = rem / DFF, ch = rem - j * DFF; const bool first = (seg & 15) == 0;
          float gm2, gm1, g0;
          if (j == 0) { gm2 = first ? 0.f : GRAW[(size_t)((seg - 1) * 4 + 0) * DFF + ch]; gm1 = first ? 0.f : GRAW[(size_t)((seg - 1) * 4 + 1) * DFF + ch]; g0 = GRAW[(size_t)(seg * 4 + 2) * DFF + ch]; }
          else { gm2 = first ? 0.f : GRAW[(size_t)((seg - 1) * 4 + 1) * DFF + ch]; gm1 = GRAW[(size_t)(seg * 4 + 2) * DFF + ch]; g0 = GRAW[(size_t)(seg * 4 + 3) * DFF + ch]; }
          const float c = cb[ch] + cw[ch] * gm2 + cw[DFF + ch] * gm1 + cw[2 * DFF + ch] * g0;
          Y[((size_t)seg * 128 + j) * DFF + ch] = f2bf(gelu1(c) * URAW[(size_t)(seg * 2 + j) * DFF + ch]); } }
    }
#endif
    xcd_barrier(xb);

#if PH & 256
    { KP p = get_params(); unsigned char* ws = p->ws;
    { Gemm g{(const bf16_t*)(ws + WS_R3), (const bf16_t*)(ws + WS_WDOWN), NPROMPT, 1024, DFF}; StaticOrder S; S.init(NPROMPT, 1024, G, bx);
      EpiSS E{(float*)(ws + WS_R1), (float*)(ws + WS_SS2)};
      gemm_phase(lds, g, S, E);
      for (int blk = bx; blk < 256; blk += G) tail_ss((const bf16_t*)(ws + WS_R3), (const bf16_t*)(ws + WS_WDOWN), DFF, (float*)(ws + WS_R1), (float*)(ws + WS_SS2), lds, blk); }
    }
#endif
    xcd_barrier(xb);

#if PH & 512
    { KP p = get_params(); unsigned char* ws = p->ws;
    { const int tid = ltid(), lane = tid & 63, wid = tid >> 6; const float* F = (const float*)(ws + WS_R1); const float* SS2 = (const float*)(ws + WS_SS2);
      for (int row = bx * 8 + wid; row < MT; row += G * 8) {
          const f32x4 s0 = *(const f32x4*)(SS2 + (size_t)row * 16), s1 = *(const f32x4*)(SS2 + (size_t)row * 16 + 4), s2 = *(const f32x4*)(SS2 + (size_t)row * 16 + 8), s3 = *(const f32x4*)(SS2 + (size_t)row * 16 + 12);
          const float ss = ((s0[0] + s0[1]) + (s0[2] + s0[3])) + ((s1[0] + s1[1]) + (s1[2] + s1[3])) + ((s2[0] + s2[1]) + (s2[2] + s2[3])) + ((s3[0] + s3[1]) + (s3[2] + s3[3]));
          const float inv = rsqrtf(ss * (1.0f / 1024.0f) + EPSV);
#pragma unroll
          for (int i = 0; i < 4; ++i) { const int c = lane * 4 + 256 * i; float* op = p->out + O_Y + (size_t)row * 1024 + c;
              const f32x4 fv = *(const f32x4*)(F + (size_t)row * 1024 + c), hv = *(const f32x4*)op, gp = *(const f32x4*)(p->in[10] + c);
              *(f32x4*)op = hv + fv * inv * gp; } } }
    }
#endif
#ifdef DUMP_OFF
    xcd_barrier(xb);
    { KP p = get_params(); const int tid = ltid();
      if (DUMP_F32) { const float* src = (const float*)(p->ws + DUMP_OFF); for (size_t i = (size_t)bx * 512 + tid; i < (size_t)MT * 1024; i += (size_t)G * 512) p->out[i] = src[i]; }
      else { const bf16_t* src = (const bf16_t*)(p->ws + DUMP_OFF); for (size_t i = (size_t)bx * 512 + tid; i < (size_t)MT * 1024; i += (size_t)G * 512) p->out[i] = bf2f(src[i]); } }
#endif
}

extern "C" void kernel_launch(void* const* d_in, const int* in_sizes, int n_in, void* d_out, int out_size, void* d_ws, size_t ws_size, hipStream_t stream) {
    static int grid = 0;
    if (grid == 0) {
        if (n_in != 29 || ws_size < WS_END) { fprintf(stderr, "kernel_launch: unexpected n_in %d / ws_size %zu (need %zu)\n", n_in, ws_size, (size_t)WS_END); grid = -1; return; }
        int dev = 0, cus = 0, per_cu = 0;
        (void)hipGetDevice(&dev); (void)hipDeviceGetAttribute(&cus, hipDeviceAttributeMultiprocessorCount, dev);
        if (hipFuncSetAttribute((const void*)mega_fwd, hipFuncAttributeMaxDynamicSharedMemorySize, LDS_BYTES) != hipSuccess) fprintf(stderr, "kernel_launch: hipFuncSetAttribute failed\n");
        if (hipOccupancyMaxActiveBlocksPerMultiprocessor(&per_cu, (const void*)mega_fwd, 512, LDS_BYTES) != hipSuccess || per_cu < 1) per_cu = 1;
        (void)hipGetLastError();
        grid = cus * per_cu; if (grid <= 0) grid = 256;
    }
    if (grid < 0) return;
    Params p{};
    for (int i = 0; i < 29; ++i) p.in[i] = (const float*)d_in[i];
    p.out = (float*)d_out; p.ws = (unsigned char*)d_ws;
    (void)hipMemsetAsync((unsigned char*)d_ws + WS_BAR, 0, 16384, stream);
    void* args[] = {&p};
    hipError_t e = hipLaunchCooperativeKernel((const void*)mega_fwd, dim3(grid), dim3(512), args, LDS_BYTES, stream);
    if (e != hipSuccess) fprintf(stderr, "cooperative launch failed: %s (grid %d)\n", hipGetErrorString(e), grid);
}
```
